# Optimizing an MI355X kernel written in HIP

```python
import jax, jax.numpy as jnp
from jax import lax
import numpy as np

D_MODEL = 1024
BATCH = 8
SEQ = 4096
DEPTH = 1

PLE_DIM = 256
HG_HEADS = 4
HG_DK = 128
HG_DV = 128
HG_KW = HG_HEADS * HG_DK
HG_VW = HG_HEADS * HG_DV
HG_CHUNK = 64
FOX_HEADS = 8
FOX_DH = 64
FOX_W = FOX_HEADS * FOX_DH
FOX_BLOCK = 128
D_FF = ((-(-8 * D_MODEL // 3) + 255) // 256) * 256
EPS = 1e-6

OFF_HG_Q = 0
OFF_HG_F = OFF_HG_Q + HG_KW
OFF_HG_I = OFF_HG_F + HG_KW
OFF_HG_G = OFF_HG_I + HG_VW
OFF_FOX_Q = OFF_HG_G + HG_VW
OFF_FOX_K = OFF_FOX_Q + FOX_W
OFF_FOX_V = OFF_FOX_K + FOX_W
OFF_FOX_F = OFF_FOX_V + FOX_W
OFF_GATE = OFF_FOX_F + FOX_HEADS
IN_COLS = OFF_GATE + 2 * D_MODEL

kernel_name = "hgrn2_fox_gated_hybrid"


def rms_norm(x, g):
    xf = x.astype(jnp.float32)
    y = xf * lax.rsqrt(jnp.mean(xf * xf, axis=-1, keepdims=True) + EPS)
    return (y * g.astype(jnp.float32)).astype(x.dtype)


def hgrn2_mixer(q, f_logit, i, g, lb, o_gain):
    B, S, _ = q.shape
    f32 = jnp.float32
    qf = jax.nn.silu(q.astype(f32))
    fg = lb + (1.0 - lb) * jax.nn.sigmoid(f_logit.astype(f32))
    kf = 1.0 - fg
    logf = jnp.log(fg)
    vf = i.astype(f32)
    n = S // HG_CHUNK

    def to_chunks(t, d):
        return t.reshape(B, n, HG_CHUNK, HG_HEADS, d).transpose(1, 0, 3, 2, 4)

    qc = to_chunks(qf, HG_DK)
    kc = to_chunks(kf, HG_DK)
    vc = to_chunks(vf, HG_DV)
    bc = jnp.cumsum(to_chunks(logf, HG_DK), axis=3)
    causal = jnp.tril(jnp.ones((HG_CHUNK, HG_CHUNK), dtype=bool))[:, :, None]

    def step(state, xs):
        qt, kt, vt, bt = xs
        inter = jnp.einsum('bhtc,bhcv->bhtv', qt * jnp.exp(bt), state)
        diff = bt[:, :, :, None, :] - bt[:, :, None, :, :]
        decay = jnp.exp(jnp.where(causal, diff, -jnp.inf))
        scores = jnp.einsum('bhtc,bhsc,bhtsc->bhts', qt, kt, decay)
        intra = jnp.einsum('bhts,bhsv->bhtv', scores, vt)
        b_last = bt[:, :, -1:, :]
        new_state = (jnp.exp(b_last[:, :, 0, :])[..., None] * state
                     + jnp.einsum('bhsc,bhsv->bhcv', kt * jnp.exp(b_last - bt), vt))
        return new_state, inter + intra

    s0 = jnp.zeros((B, HG_HEADS, HG_DK, HG_DV), f32)
    _, o = lax.scan(step, s0, (qc, kc, vc, bc))
    o = o.transpose(1, 0, 3, 2, 4).reshape(B, S, HG_HEADS, HG_DV)
    o = rms_norm(o, o_gain).reshape(B, S, HG_VW)
    o = o * jax.nn.silu(g.astype(f32))
    return o.astype(q.dtype)


def forgetting_attention(q, k, v, f_logit, f_bias, q_gain, k_gain):
    B, S, _ = q.shape
    f32 = jnp.float32

    def heads(t):
        return t.reshape(B, S, FOX_HEADS, FOX_DH).transpose(0, 2, 1, 3)

    qh = rms_norm(heads(q), q_gain).astype(f32)
    kh = rms_norm(heads(k), k_gain).astype(f32)
    vh = heads(v)
    logf = jax.nn.log_sigmoid(f_logit.astype(f32) + f_bias.astype(f32))
    c = jnp.cumsum(logf, axis=1).transpose(0, 2, 1)
    scale = FOX_DH ** -0.5
    outs = []
    for blk in range(S // FOX_BLOCK):
        t0 = blk * FOX_BLOCK
        t1 = t0 + FOX_BLOCK
        s = jnp.einsum('bhtd,bhsd->bhts', qh[:, :, t0:t1], kh[:, :, :t1]) * scale
        s = s + c[:, :, t0:t1, None] - c[:, :, None, :t1]
        mask = (t0 + jnp.arange(FOX_BLOCK))[:, None] >= jnp.arange(t1)[None, :]
        s = jnp.where(mask, s, -jnp.inf)
        pr = jax.nn.softmax(s, axis=-1).astype(vh.dtype)
        outs.append(jnp.einsum('bhts,bhsd->bhtd', pr, vh[:, :, :t1]))
    o = jnp.concatenate(outs, axis=2)
    return o.transpose(0, 2, 1, 3).reshape(B, S, FOX_W)


def setup_inputs(seed: int = 0) -> dict:
    key = jax.random.key(seed)
    ks = jax.random.split(key, 24)
    f32 = jnp.float32

    def w(k, shape, fan_in):
        return jax.random.normal(k, shape, f32) * (fan_in ** -0.5)

    def gain(k, shape):
        return 1.0 + 0.02 * jax.random.normal(k, shape, f32)

    return {
        "x": jax.random.normal(ks[0], (BATCH, SEQ, D_MODEL), f32),
        "p": jax.random.normal(ks[1], (DEPTH, BATCH, SEQ, PLE_DIM), f32),
        "norm_mix_g": gain(ks[2], (DEPTH, D_MODEL)),
        "w_in": w(ks[3], (DEPTH, D_MODEL, IN_COLS), D_MODEL),
        "hg_lb_logits": 0.1 * jax.random.normal(ks[4], (DEPTH + 1, HG_KW), f32),
        "hg_onorm_g": gain(ks[5], (DEPTH, HG_DV)),
        "fox_f_bias": jax.random.uniform(ks[6], (DEPTH, FOX_HEADS), f32, minval=1.0, maxval=4.0),
        "fox_q_norm_g": gain(ks[7], (DEPTH, FOX_DH)),
        "fox_k_norm_g": gain(ks[8], (DEPTH, FOX_DH)),
        "w_branch_a": w(ks[9], (DEPTH, HG_VW, D_MODEL), HG_VW),
        "w_branch_b": w(ks[10], (DEPTH, FOX_W, D_MODEL), FOX_W),
        "w_out": w(ks[11], (DEPTH, D_MODEL, D_MODEL), D_MODEL),
        "norm_ffn_g": gain(ks[12], (DEPTH, D_MODEL)),
        "w_ffn_gate": w(ks[13], (DEPTH, D_MODEL, D_FF), D_MODEL),
        "w_ffn_up": w(ks[14], (DEPTH, D_MODEL, D_FF), D_MODEL),
        "w_ffn_down": w(ks[15], (DEPTH, D_FF, D_MODEL), D_FF),
        "norm_ple_g": gain(ks[16], (DEPTH, D_MODEL)),
        "w_ple_gate": w(ks[17], (DEPTH, D_MODEL, D_MODEL), D_MODEL),
        "w_ple_proj": w(ks[18], (DEPTH, PLE_DIM, D_MODEL), PLE_DIM),
    }


def reference(x, p, norm_mix_g, w_in, hg_lb_logits, hg_onorm_g, fox_f_bias, fox_q_norm_g,
              fox_k_norm_g, w_branch_a, w_branch_b, w_out, norm_ffn_g, w_ffn_gate, w_ffn_up,
              w_ffn_down, norm_ple_g, w_ple_gate, w_ple_proj):
    lower_bounds = jnp.cumsum(jax.nn.softmax(hg_lb_logits.astype(jnp.float32), axis=0), axis=0)
    for layer in range(DEPTH):
        h = rms_norm(x, norm_mix_g[layer])
        z = h @ w_in[layer]
        y_a = hgrn2_mixer(z[..., OFF_HG_Q:OFF_HG_F], z[..., OFF_HG_F:OFF_HG_I],
                          z[..., OFF_HG_I:OFF_HG_G], z[..., OFF_HG_G:OFF_FOX_Q],
                          lower_bounds[layer], hg_onorm_g[layer])
        y_b = forgetting_attention(z[..., OFF_FOX_Q:OFF_FOX_K], z[..., OFF_FOX_K:OFF_FOX_V],
                                   z[..., OFF_FOX_V:OFF_FOX_F], z[..., OFF_FOX_F:OFF_GATE],
                                   fox_f_bias[layer], fox_q_norm_g[layer], fox_k_norm_g[layer])
        gate_a = jax.nn.sigmoid(z[..., OFF_GATE:OFF_GATE + D_MODEL])
        gate_b = jax.nn.sigmoid(z[..., OFF_GATE + D_MODEL:IN_COLS])
        merged = gate_a * (y_a @ w_branch_a[layer]) + gate_b * (y_b @ w_branch_b[layer])
        x = x + merged @ w_out[layer]
        hf = rms_norm(x, norm_ffn_g[layer])
        x = x + (jax.nn.silu(hf @ w_ffn_gate[layer]) * (hf @ w_ffn_up[layer])) @ w_ffn_down[layer]
        hp = rms_norm(x, norm_ple_g[layer])
        x = x + jax.nn.sigmoid(hp @ w_ple_gate[layer]) * (p[layer] @ w_ple_proj[layer])
    return x
```

```cpp
#include <hip/hip_runtime.h>
#include <hip/hip_cooperative_groups.h>
#include <cstdio>
#include <cstdint>
#include <cmath>
namespace cg = cooperative_groups;

#ifndef USE_FAST_GEMM
#define USE_FAST_GEMM 1
#endif
#ifndef USE_FAST_MIX
#define USE_FAST_MIX 0
#endif
#ifndef ONE_LAUNCH
#define ONE_LAUNCH 0
#endif

#define GAS __attribute__((address_space(1)))
#define LAS __attribute__((address_space(3)))
typedef unsigned short bf16_t;
typedef short bf16x8 __attribute__((ext_vector_type(8)));
typedef float f32x4 __attribute__((ext_vector_type(4)));
typedef float f32x2 __attribute__((ext_vector_type(2)));
typedef unsigned u32x4 __attribute__((ext_vector_type(4)));
typedef unsigned u32x2 __attribute__((ext_vector_type(2)));

constexpr int BATCH = 8, SEQ = 4096, DMODEL = 1024, M = BATCH * SEQ;
constexpr int INC = 5640, ZLD = 5632, DFF = 2816, PLE = 256;
constexpr int ZC_Q = 0, ZC_F = 512, ZC_I = 1024, ZC_G = 1536, ZC_FQ = 2048, ZC_FK = 2560, ZC_FV = 3072, ZC_GA = 3584, ZC_GB = 4608;
constexpr float EPS = 1e-6f;
constexpr float LOG2E = 1.4426950408889634f;
constexpr float C2 = 0.125f * 1.4426950408889634f;
constexpr int NWAVES = 8, NTHR = 512;

constexpr size_t MiB = 1u << 20;
constexpr size_t WS_CTL = 0, CTL_ZERO_BYTES = 1 * MiB;
constexpr size_t WS_WIN = 1 * MiB, WS_WA = 12 * MiB, WS_WB = 13 * MiB, WS_WOUT = 14 * MiB, WS_WGU = 16 * MiB, WS_WD = 27 * MiB, WS_WPG = 33 * MiB, WS_WPP = 35 * MiB;
constexpr size_t WS_RSTD = 36 * MiB, WS_LF = 36 * MiB + 256 * 1024, WS_CD = 38 * MiB, WS_SSQ1 = 40 * MiB, WS_SSQ2 = 42 * MiB;
constexpr size_t WS_XB = 44 * MiB, WS_PB = 108 * MiB, WS_Z = 124 * MiB;
constexpr size_t WS_X1B = WS_Z, WS_H = WS_Z + 64 * MiB, WS_PP = WS_Z + 240 * MiB, WS_END = WS_Z + 352 * MiB;
static_assert(WS_END <= 512 * MiB, "ws map");
constexpr int LDS_BYTES = 155648;

__device__ __forceinline__ unsigned f2bf(float f) { unsigned u = __builtin_bit_cast(unsigned, f); return (u + 0x7fffu + ((u >> 16) & 1u)) >> 16; }
__device__ __forceinline__ unsigned pk2(float lo, float hi) { return f2bf(lo) | (f2bf(hi) << 16); }
__device__ __forceinline__ float bflo(unsigned w) { return __builtin_bit_cast(float, w << 16); }
__device__ __forceinline__ float bfhi(unsigned w) { return __builtin_bit_cast(float, w & 0xffff0000u); }
__device__ __forceinline__ float bf1(bf16_t h) { return __builtin_bit_cast(float, (unsigned)h << 16); }
__device__ __forceinline__ float wave_sum(float v) {
#pragma unroll
    for (int o = 1; o < 64; o <<= 1) v += __shfl_xor(v, o);
    return v;
}
__device__ __forceinline__ float sigmoidf_(float v) { return 1.0f / (1.0f + __expf(-v)); }
__device__ __forceinline__ void unpack8(u32x4 w, float (&f)[8]) { f[0] = bflo(w.x); f[1] = bfhi(w.x); f[2] = bflo(w.y); f[3] = bfhi(w.y); f[4] = bflo(w.z); f[5] = bfhi(w.z); f[6] = bflo(w.w); f[7] = bfhi(w.w); }
__device__ __forceinline__ u32x4 pack8(const float (&f)[8]) { u32x4 w; w.x = pk2(f[0], f[1]); w.y = pk2(f[2], f[3]); w.z = pk2(f[4], f[5]); w.w = pk2(f[6], f[7]); return w; }
#define LDS_WAIT() asm volatile("s_waitcnt lgkmcnt(0)" ::: "memory")

namespace pg8 {
constexpr int BM = 256, BK = 64, HALF = 128, HTB = HALF * BK * 2, STAGE_BYTES = 8 * HTB, NXCD = 8, WGM = 8;
__host__ __device__ __forceinline__ int lds_byte(int r, int c) { const int st = (r >> 4) * 2 + (c >> 5), rr = r & 15, cc = c & 31, ob = rr * 64 + cc * 2; return st * 1024 + (ob ^ (((ob >> 9) & 1) << 5)); }
__host__ __device__ __forceinline__ void stage_rc(int b, int& R, int& C) { const int st = b / 1024, sb = b % 1024, swz = sb ^ (((sb >> 9) & 1) << 5); R = (st >> 1) * 16 + swz / 64; C = (st & 1) * 32 + (swz % 64) / 2; }
__host__ __device__ __forceinline__ int perm32(int rho) { const int n = rho >> 4, i = rho & 15; return 8 * (i >> 2) + 4 * n + (i & 3); }
struct Unit { int pm, pn; };
struct Gemm { const bf16_t* A; const bf16_t* Bt; int M, N, K, lda; };
struct StaticOrder {
    int nM, nN, nwg, G, c;
    __host__ __device__ void init(int M_, int N_, int G_, int c_) { nM = M_ / BM; nN = N_ / BM; nwg = nM * nN; G = G_; c = c_; }
    __host__ __device__ bool next(int i, Unit& u) const {
        const long L = (long)i * G + c; if (L >= nwg) return false;
        int wgid = (int)L; { const int q = nwg / NXCD, r = nwg % NXCD, xcd = wgid % NXCD, off = wgid / NXCD; wgid = (xcd < r ? xcd * (q + 1) : r * (q + 1) + (xcd - r) * q) + off; }
        const int nig = WGM * nN, gid = wgid / nig, fm = gid * WGM, gsz = (nM - fm) < WGM ? (nM - fm) : WGM;
        u.pm = fm + ((wgid % nig) % gsz); u.pn = (wgid % nig) / gsz; return true;
    }
};
typedef f32x4 Acc[2][2][4][2];

template <class Epi, bool ALIGN_EPI = true, bool SP2 = true>
__device__ __forceinline__ void gemm_phase(LAS unsigned char* lds, const Gemm g, const StaticOrder& S, const Epi& E) {
    const int tid = threadIdx.x, wid = __builtin_amdgcn_readfirstlane(tid >> 6), lane = tid & 63, wr = wid >> 2, wc = wid & 3, fr = lane & 15, fq = lane >> 4;
    const int K = g.K, nt = K / BK;
    unsigned voffA[2], voffB[2];
#pragma unroll
    for (int i = 0; i < 2; ++i) { int R, C; stage_rc(tid * 16 + i * 8192, R, C); const int Rb = (R & ~31) + perm32(R & 31);
        voffA[i] = (unsigned)(R * g.lda + C) * 2u; voffB[i] = (unsigned)(Rb * K + C) * 2u; }
    const size_t kstep = (size_t)(BK * 2);
    const size_t hstepA = (size_t)HALF * g.lda * 2, hstepB = (size_t)HALF * K * 2;
    const size_t tstepA = 2 * hstepA, tstepB = 2 * hstepB;
    const unsigned ldsw = (unsigned)wid * 1024u;
    const int aoff = lds_byte(wr * 64 + fr, fq * 8), boff = lds_byte(wc * 32 + fr, fq * 8);
#define PG8_SA(b, h) (((b) * 2 + (h)) * HTB)
#define PG8_SB(b, h) ((4 + (b) * 2 + (h)) * HTB)
#define PG8_STAGE(bufoff, gbase, voff) do { _Pragma("unroll") for (int _i = 0; _i < 2; ++_i) \
        __builtin_amdgcn_global_load_lds((const unsigned*)((const char*)(gbase) + (voff)[_i]), (LAS unsigned*)(lds + (bufoff) + ldsw + _i * 8192), 16, 0, 0); } while (0)
#define PG8_LDA(dst, b, h) do { _Pragma("unroll") for (int m = 0; m < 4; ++m) _Pragma("unroll") for (int k = 0; k < 2; ++k) dst[m][k] = *(const LAS bf16x8*)(lds + PG8_SA(b, h) + aoff + m * 2048 + k * 1024); } while (0)
#define PG8_LDB(dst, b, h) do { _Pragma("unroll") for (int n = 0; n < 2; ++n) _Pragma("unroll") for (int k = 0; k < 2; ++k) dst[n][k] = *(const LAS bf16x8*)(lds + PG8_SB(b, h) + boff + n * 2048 + k * 1024); } while (0)
#define PG8_MMA(ai, bj, At, Bt) do { __builtin_amdgcn_s_setprio(1); _Pragma("unroll") for (int m = 0; m < 4; ++m) _Pragma("unroll") for (int n = 0; n < 2; ++n) _Pragma("unroll") for (int k = 0; k < 2; ++k) \
        acc[ai][bj][m][n] = __builtin_amdgcn_mfma_f32_16x16x32_bf16(Bt[n][k], At[m][k], acc[ai][bj][m][n], 0, 0, 0); __builtin_amdgcn_s_setprio(0); } while (0)
#define PG8_WAIT_V(n) asm volatile("s_waitcnt vmcnt(" #n ")" ::: "memory")
#define PG8_WAIT_L(n) asm volatile("s_waitcnt lgkmcnt(" #n ")" ::: "memory")
#define PG8_BAR __builtin_amdgcn_s_barrier()
#define PG8_SCHED __builtin_amdgcn_sched_barrier(0)
    Unit cur, nxt; int ui = 0;
    if (!S.next(0, cur)) return;
    Acc acc;
#pragma unroll
    for (int a = 0; a < 2; ++a)
#pragma unroll
        for (int b = 0; b < 2; ++b)
#pragma unroll
            for (int m = 0; m < 4; ++m)
#pragma unroll
                for (int n = 0; n < 2; ++n) acc[a][b][m][n] = (f32x4){0.f, 0.f, 0.f, 0.f};
    bf16x8 At[4][2], B0[2][2], B1[2][2];
    const char* cA = (const char*)g.A + (size_t)cur.pm * tstepA; const char* cB = (const char*)g.Bt + (size_t)cur.pn * tstepB;
    if constexpr (SP2) {
        PG8_STAGE(PG8_SB(0, 0), cB, voffB); PG8_STAGE(PG8_SB(0, 1), cB + hstepB, voffB); PG8_STAGE(PG8_SA(0, 0), cA, voffA); PG8_STAGE(PG8_SA(0, 1), cA + hstepA, voffA);
        if (wr == 1) PG8_BAR;
        PG8_WAIT_V(2); PG8_BAR;
        PG8_STAGE(PG8_SB(1, 0), cB + kstep, voffB); PG8_STAGE(PG8_SA(1, 0), cA + kstep, voffA); PG8_STAGE(PG8_SB(1, 1), cB + hstepB + kstep, voffB);
        PG8_WAIT_V(6); PG8_BAR;
    }
    for (;;) {
        const bool has_next = S.next(ui + 1, nxt);
        const char* nA = has_next ? (const char*)g.A + (size_t)nxt.pm * tstepA : cA; const char* nB = has_next ? (const char*)g.Bt + (size_t)nxt.pn * tstepB : cB;
        for (int t = 0; t < nt; t += 2) {
            const bool last = (t == nt - 2);
            const char* a1 = cA + (size_t)(t + 1) * kstep;
            const char* a2 = last ? nA : cA + (size_t)(t + 2) * kstep; const char* b2 = last ? nB : cB + (size_t)(t + 2) * kstep;
            const char* a3 = a2 + kstep; const char* b3 = b2 + kstep;
            PG8_LDB(B0, 0, 0); PG8_LDB(B1, 0, 1); PG8_SCHED; PG8_LDA(At, 0, 0); PG8_STAGE(PG8_SA(1, 1), a1 + hstepA, voffA);
            PG8_WAIT_V(8); PG8_WAIT_L(0); PG8_BAR; PG8_MMA(0, 0, At, B0); PG8_MMA(0, 1, At, B1); PG8_BAR; PG8_SCHED;
            PG8_LDA(At, 0, 1); PG8_STAGE(PG8_SB(0, 0), b2, voffB); PG8_STAGE(PG8_SB(0, 1), b2 + hstepB, voffB); PG8_STAGE(PG8_SA(0, 0), a2, voffA);
            PG8_WAIT_V(8); PG8_WAIT_L(0); PG8_BAR; PG8_MMA(1, 0, At, B0); PG8_MMA(1, 1, At, B1); PG8_BAR; PG8_SCHED;
            PG8_LDB(B0, 1, 0); PG8_LDB(B1, 1, 1); PG8_SCHED; PG8_LDA(At, 1, 0); PG8_STAGE(PG8_SA(0, 1), a2 + hstepA, voffA);
            PG8_WAIT_V(8); PG8_WAIT_L(0); PG8_BAR; PG8_MMA(0, 0, At, B0); PG8_MMA(0, 1, At, B1); PG8_BAR; PG8_SCHED;
            PG8_LDA(At, 1, 1); PG8_STAGE(PG8_SB(1, 0), b3, voffB); PG8_STAGE(PG8_SB(1, 1), b3 + hstepB, voffB); PG8_STAGE(PG8_SA(1, 0), a3, voffA);
            PG8_WAIT_V(8); PG8_WAIT_L(0); PG8_BAR; PG8_MMA(1, 0, At, B0); PG8_MMA(1, 1, At, B1); PG8_BAR; PG8_SCHED;
        }
        if constexpr (ALIGN_EPI) { if (wr == 0) PG8_BAR; }
        E(acc, cur, wr, wc, fr, fq);
        if (!has_next) break;
#pragma unroll
        for (int a = 0; a < 2; ++a)
#pragma unroll
            for (int b = 0; b < 2; ++b)
#pragma unroll
                for (int m = 0; m < 4; ++m)
#pragma unroll
                    for (int n = 0; n < 2; ++n) acc[a][b][m][n] = (f32x4){0.f, 0.f, 0.f, 0.f};
        cur = nxt; cA = nA; cB = nB; ++ui;
        if constexpr (ALIGN_EPI) { if (wr == 1) PG8_BAR; }
    }
    PG8_WAIT_V(0);
    if constexpr (!ALIGN_EPI) { if (wr == 0) PG8_BAR; }
    PG8_BAR;
#undef PG8_SA
#undef PG8_SB
#undef PG8_STAGE
#undef PG8_LDA
#undef PG8_LDB
#undef PG8_MMA
#undef PG8_WAIT_V
#undef PG8_WAIT_L
#undef PG8_BAR
#undef PG8_SCHED
}

template <class Epi>
__device__ __forceinline__ void gemm_naive(const Gemm g, const StaticOrder& S, const Epi& E) {
    const int tid = threadIdx.x, wid = tid >> 6, lane = tid & 63, wr = wid >> 2, wc = wid & 3, fr = lane & 15, fq = lane >> 4;
    Unit cur;
    for (int ui = 0; S.next(ui, cur); ++ui) {
        Acc acc;
#pragma unroll
        for (int a = 0; a < 2; ++a)
#pragma unroll
            for (int b = 0; b < 2; ++b)
#pragma unroll
                for (int m = 0; m < 4; ++m)
#pragma unroll
                    for (int n = 0; n < 2; ++n) acc[a][b][m][n] = (f32x4){0.f, 0.f, 0.f, 0.f};
        const char* Abase = (const char*)g.A; const char* Bbase = (const char*)g.Bt;
        const unsigned ao0 = (unsigned)((cur.pm * 256 + wr * 64 + fr) * g.lda) * 2u, aos = (unsigned)(16 * g.lda) * 2u;
        const unsigned bo0 = (unsigned)((cur.pn * 256 + wc * 32 + 8 * fq) * g.K) * 2u, bos = (unsigned)g.K * 2u;
#pragma unroll 1
        for (int k = 0; k < g.K; k += 4) {
#pragma unroll
            for (int bj = 0; bj < 2; ++bj) {
                u32x2 bw[2][4];
#pragma unroll
                for (int n = 0; n < 2; ++n)
#pragma unroll
                    for (int e = 0; e < 4; ++e) bw[n][e] = *(const u32x2*)(Bbase + (bo0 + (unsigned)(bj * 128 + 4 * n + e) * bos + (unsigned)k * 2u));
#pragma unroll
                for (int ai = 0; ai < 2; ++ai)
#pragma unroll
                    for (int m = 0; m < 4; ++m) {
                        const u32x2 aw = *(const u32x2*)(Abase + (ao0 + (unsigned)(ai * 8 + m) * aos + (unsigned)k * 2u));
                        const float a0 = bflo(aw.x), a1 = bfhi(aw.x), a2 = bflo(aw.y), a3 = bfhi(aw.y);
#pragma unroll
                        for (int n = 0; n < 2; ++n)
#pragma unroll
                            for (int e = 0; e < 4; ++e) { const u32x2 b = bw[n][e];
                                acc[ai][bj][m][n][e] += (a0 * bflo(b.x) + a1 * bfhi(b.x)) + (a2 * bflo(b.y) + a3 * bfhi(b.y)); }
                    }
            }
        }
        E(acc, cur, wr, wc, fr, fq);
    }
}

__device__ __forceinline__ void get8(const Acc& acc, int ai, int bj, int m, float (&v)[8]) {
#pragma unroll
    for (int e = 0; e < 4; ++e) { v[e] = acc[ai][bj][m][0][e]; v[4 + e] = acc[ai][bj][m][1][e]; }
}

struct EpiIn {
    bf16_t* Z; const float* rstd; const float* lbl; const float* qg; const float* kg;
    template <int MODE> __device__ __forceinline__ void run(const Acc& acc, const Unit& u, int wr, int wc, int fr, int fq) const {
        constexpr bool HP = (MODE == 3 || MODE == 4);
        int colb[2];
#pragma unroll
        for (int bj = 0; bj < 2; ++bj) colb[bj] = HP ? (u.pn * 256 + 64 * wc + 32 * bj + 8 * fq) : (u.pn * 256 + 128 * bj + 32 * wc + 8 * fq);
        float aux[2][8];
#pragma unroll
        for (int bj = 0; bj < 2; ++bj)
#pragma unroll
            for (int j = 0; j < 8; ++j) {
                if (MODE == 1) { const int k = colb[bj] - ZC_F + j; const float l0 = lbl[k], l1 = lbl[512 + k]; aux[bj][j] = 1.0f / (1.0f + __expf(l1 - l0)); }
                else if (MODE == 3) aux[bj][j] = qg[(colb[bj] + j) & 63] * C2;
                else if (MODE == 4) aux[bj][j] = kg[(colb[bj] + j) & 63];
                else aux[bj][j] = 0.f;
            }
#pragma unroll
        for (int ai = 0; ai < 2; ++ai)
#pragma unroll
            for (int m = 0; m < 4; ++m) {
                const int row = u.pm * 256 + ai * 128 + wr * 64 + m * 16 + fr;
                const float rs = rstd[row];
                float v[2][8];
#pragma unroll
                for (int bj = 0; bj < 2; ++bj) { get8(acc, ai, bj, m, v[bj]);
#pragma unroll
                    for (int j = 0; j < 8; ++j) v[bj][j] *= rs; }
                if (HP) {
                    float ss = 0.f;
#pragma unroll
                    for (int bj = 0; bj < 2; ++bj)
#pragma unroll
                        for (int j = 0; j < 8; ++j) ss += v[bj][j] * v[bj][j];
                    ss += __shfl_xor(ss, 16); ss += __shfl_xor(ss, 32);
                    const float rn = 1.0f / sqrtf(ss * (1.0f / 64.0f) + EPS);
#pragma unroll
                    for (int bj = 0; bj < 2; ++bj)
#pragma unroll
                        for (int j = 0; j < 8; ++j) v[bj][j] = v[bj][j] * rn * aux[bj][j];
                }
#pragma unroll
                for (int bj = 0; bj < 2; ++bj) {
#pragma unroll
                    for (int j = 0; j < 8; ++j) {
                        float x = v[bj][j];
                        if (MODE == 0) x = x * sigmoidf_(x);
                        else if (MODE == 1) { const float lb = aux[bj][j]; const float fg = lb + (1.0f - lb) * sigmoidf_(x); x = __logf(fg); }
                        else if (MODE == 5) x = sigmoidf_(x);
                        v[bj][j] = x;
                    }
                    *(u32x4*)(Z + (size_t)row * ZLD + colb[bj]) = pack8(v[bj]);
                }
            }
    }
    __device__ __forceinline__ void operator()(const Acc& acc, const Unit& u, int wr, int wc, int fr, int fq) const {
        const int pn = u.pn;
        if (pn < 2) run<0>(acc, u, wr, wc, fr, fq);
        else if (pn < 4) run<1>(acc, u, wr, wc, fr, fq);
        else if (pn < 6) run<2>(acc, u, wr, wc, fr, fq);
        else if (pn < 8) run<0>(acc, u, wr, wc, fr, fq);
        else if (pn < 10) run<3>(acc, u, wr, wc, fr, fq);
        else if (pn < 12) run<4>(acc, u, wr, wc, fr, fq);
        else if (pn < 14) run<2>(acc, u, wr, wc, fr, fq);
        else run<5>(acc, u, wr, wc, fr, fq);
    }
};

struct EpiGate {
    bf16_t* out; int ldo; const bf16_t* gate; int ldg; bool has_add;
    __device__ __forceinline__ void operator()(const Acc& acc, const Unit& u, int wr, int wc, int fr, int fq) const {
#pragma unroll
        for (int ai = 0; ai < 2; ++ai)
#pragma unroll
            for (int m = 0; m < 4; ++m) {
                const int row = u.pm * 256 + ai * 128 + wr * 64 + m * 16 + fr;
#pragma unroll
                for (int bj = 0; bj < 2; ++bj) {
                    const int col = u.pn * 256 + 128 * bj + 32 * wc + 8 * fq;
                    float v[8], gt[8]; get8(acc, ai, bj, m, v);
                    unpack8(*(const u32x4*)(gate + (size_t)row * ldg + col), gt);
                    bf16_t* op = out + (size_t)row * ldo + col;
                    if (has_add) { float ad[8]; unpack8(*(const u32x4*)op, ad);
#pragma unroll
                        for (int j = 0; j < 8; ++j) v[j] = ad[j] + gt[j] * v[j]; }
                    else {
#pragma unroll
                        for (int j = 0; j < 8; ++j) v[j] = gt[j] * v[j]; }
                    *(u32x4*)op = pack8(v);
                }
            }
    }
};

struct EpiResid {
    const float* xin; float* out; bf16_t* xb; float* ssq;
    __device__ __forceinline__ void operator()(const Acc& acc, const Unit& u, int wr, int wc, int fr, int fq) const {
#pragma unroll
        for (int ai = 0; ai < 2; ++ai)
#pragma unroll
            for (int m = 0; m < 4; ++m) {
                const int row = u.pm * 256 + ai * 128 + wr * 64 + m * 16 + fr;
                float ss = 0.f;
#pragma unroll
                for (int bj = 0; bj < 2; ++bj) {
                    const int col = u.pn * 256 + 128 * bj + 32 * wc + 8 * fq;
                    const size_t off = (size_t)row * DMODEL + col;
                    const f32x4 x0 = *(const f32x4*)(xin + off), x1 = *(const f32x4*)(xin + off + 4);
                    float v[8]; get8(acc, ai, bj, m, v);
#pragma unroll
                    for (int j = 0; j < 4; ++j) { v[j] += x0[j]; v[4 + j] += x1[j]; }
#pragma unroll
                    for (int j = 0; j < 8; ++j) ss += v[j] * v[j];
                    *(f32x4*)(out + off) = (f32x4){v[0], v[1], v[2], v[3]}; *(f32x4*)(out + off + 4) = (f32x4){v[4], v[5], v[6], v[7]};
                    *(u32x4*)(xb + off) = pack8(v);
                }
                ss += __shfl_xor(ss, 16); ss += __shfl_xor(ss, 32);
                if (fq == 0) ssq[(size_t)row * 16 + u.pn * 4 + wc] = ss;
            }
    }
};
__device__ __forceinline__ float rstd_from_ssq(const float* ssq, int row) {
    const f32x4* p = (const f32x4*)(ssq + (size_t)row * 16);
    const f32x4 a = p[0], b = p[1], c = p[2], d = p[3];
    const float s = ((a[0] + a[1]) + (a[2] + a[3])) + ((b[0] + b[1]) + (b[2] + b[3])) + ((c[0] + c[1]) + (c[2] + c[3])) + ((d[0] + d[1]) + (d[2] + d[3]));
    return 1.0f / sqrtf(s * (1.0f / DMODEL) + EPS);
}
struct EpiSwiglu {
    bf16_t* H; const float* ssq;
    __device__ __forceinline__ void operator()(const Acc& acc, const Unit& u, int wr, int wc, int fr, int fq) const {
#pragma unroll
        for (int ai = 0; ai < 2; ++ai)
#pragma unroll
            for (int m = 0; m < 4; ++m) {
                const int row = u.pm * 256 + ai * 128 + wr * 64 + m * 16 + fr;
                const float rs = rstd_from_ssq(ssq, row);
                float gv[8], uv[8]; get8(acc, ai, 0, m, gv); get8(acc, ai, 1, m, uv);
#pragma unroll
                for (int j = 0; j < 8; ++j) { const float gg = gv[j] * rs; gv[j] = gg * sigmoidf_(gg) * (uv[j] * rs); }
                *(u32x4*)(H + (size_t)row * DFF + u.pn * 128 + 32 * wc + 8 * fq) = pack8(gv);
            }
    }
};
struct EpiPlain {
    bf16_t* out; int ldo;
    __device__ __forceinline__ void operator()(const Acc& acc, const Unit& u, int wr, int wc, int fr, int fq) const {
#pragma unroll
        for (int ai = 0; ai < 2; ++ai)
#pragma unroll
            for (int m = 0; m < 4; ++m) {
                const int row = u.pm * 256 + ai * 128 + wr * 64 + m * 16 + fr;
#pragma unroll
                for (int bj = 0; bj < 2; ++bj) { float v[8]; get8(acc, ai, bj, m, v); *(u32x4*)(out + (size_t)row * ldo + u.pn * 256 + 128 * bj + 32 * wc + 8 * fq) = pack8(v); }
            }
    }
};
struct EpiPle {
    float* out; const bf16_t* pp; const float* ssq;
    __device__ __forceinline__ void operator()(const Acc& acc, const Unit& u, int wr, int wc, int fr, int fq) const {
#pragma unroll
        for (int ai = 0; ai < 2; ++ai)
#pragma unroll
            for (int m = 0; m < 4; ++m) {
                const int row = u.pm * 256 + ai * 128 + wr * 64 + m * 16 + fr;
                const float rs = rstd_from_ssq(ssq, row);
#pragma unroll
                for (int bj = 0; bj < 2; ++bj) {
                    const int col = u.pn * 256 + 128 * bj + 32 * wc + 8 * fq;
                    const size_t off = (size_t)row * DMODEL + col;
                    float v[8], pv[8]; get8(acc, ai, bj, m, v); unpack8(*(const u32x4*)(pp + off), pv);
                    const f32x4 x0 = *(const f32x4*)(out + off), x1 = *(const f32x4*)(out + off + 4);
#pragma unroll
                    for (int j = 0; j < 4; ++j) { v[j] = x0[j] + sigmoidf_(v[j] * rs) * pv[j]; v[4 + j] = x1[j] + sigmoidf_(v[4 + j] * rs) * pv[4 + j]; }
                    *(f32x4*)(out + off) = (f32x4){v[0], v[1], v[2], v[3]}; *(f32x4*)(out + off + 4) = (f32x4){v[4], v[5], v[6], v[7]};
                }
            }
    }
};
}

struct Args { const float* in[19]; float* out; unsigned char* ws; int ph; int pad; };
struct Frame {
    LAS unsigned char* lds;
    int tid, lane, wave, G;
    const float* in[19]; float* out; unsigned char* ws;
};
enum { I_X = 0, I_P, I_GMIX, I_WIN, I_LBL, I_ONG, I_FBIAS, I_QG, I_KG, I_WA, I_WB, I_WOUT, I_GFFN, I_WG, I_WU, I_WD, I_GPLE, I_WPG, I_WPP };

__device__ __forceinline__ void p0_tr_item(const float* W, int Nsrc, int K, bf16_t* WT, int dst_row0, int src_col0, int k0, const float* gain, LAS float* scr, int lane) {
#pragma unroll 8
    for (int i = 0; i < 32; ++i) { const int kk = 2 * i + (lane >> 5); float v = W[(size_t)(k0 + kk) * Nsrc + src_col0 + (lane & 31)]; if (gain) v *= gain[k0 + kk]; scr[kk * 33 + (lane & 31)] = v; }
    LDS_WAIT(); asm volatile("" ::: "memory");
    const int c = lane & 7;
#pragma unroll
    for (int j = 0; j < 4; ++j) { const int n = (lane >> 3) + 8 * j; const LAS float* s = scr + (8 * c) * 33 + n;
        u32x4 o; o.x = pk2(s[0 * 33], s[1 * 33]); o.y = pk2(s[2 * 33], s[3 * 33]); o.z = pk2(s[4 * 33], s[5 * 33]); o.w = pk2(s[6 * 33], s[7 * 33]);
        *(u32x4*)(WT + (size_t)(dst_row0 + n) * K + k0 + 8 * c) = o; }
    LDS_WAIT(); asm volatile("" ::: "memory");
}
__device__ __forceinline__ float log_sigmoid(float v) { return v < 0.f ? v - log1pf(expf(v)) : -log1pf(expf(-v)); }

__device__ __forceinline__ void p0_prologue(Frame& F) {
    LAS float* scr = (LAS float*)(F.lds + F.wave * 16384);
    const int gw = blockIdx.x * NWAVES + F.wave, NGW = F.G * NWAVES;
    unsigned char* ws = F.ws;
    constexpr int IT0 = 16 * 176, IT1 = 8 * 32, IT2 = 8 * 32, IT3 = 16 * 32, IT4 = 16 * 176, IT5 = 44 * 32, IT6 = 16 * 32, IT7 = 4 * 32;
    constexpr int NITEMS = IT0 + IT1 + IT2 + IT3 + IT4 + IT5 + IT6 + IT7;
    for (int it = gw; it < NITEMS; it += NGW) {
        int r = it;
        if (r < IT0) { const int kb = r / 176, nb = r % 176, n0 = nb * 32, pn = n0 >> 8, rho = n0 & 255;
            int zc = n0; if (pn >= 8 && pn < 12) { const int bj = rho >> 7, wc = (rho >> 5) & 3; zc = pn * 256 + 64 * wc + 32 * bj; }
            const int src = zc < ZC_GA ? zc : zc + 8;
            p0_tr_item(F.in[I_WIN], INC, 1024, (bf16_t*)(ws + WS_WIN), n0, src, kb * 64, F.in[I_GMIX], scr, F.lane); continue; } r -= IT0;
        if (r < IT1) { p0_tr_item(F.in[I_WA], 1024, 512, (bf16_t*)(ws + WS_WA), (r % 32) * 32, (r % 32) * 32, (r / 32) * 64, nullptr, scr, F.lane); continue; } r -= IT1;
        if (r < IT2) { p0_tr_item(F.in[I_WB], 1024, 512, (bf16_t*)(ws + WS_WB), (r % 32) * 32, (r % 32) * 32, (r / 32) * 64, nullptr, scr, F.lane); continue; } r -= IT2;
        if (r < IT3) { p0_tr_item(F.in[I_WOUT], 1024, 1024, (bf16_t*)(ws + WS_WOUT), (r % 32) * 32, (r % 32) * 32, (r / 32) * 64, nullptr, scr, F.lane); continue; } r -= IT3;
        if (r < IT4) { const int kb = r / 176, nb = r % 176, n0 = nb * 32, pn = n0 >> 8, rho = n0 & 255, bj = rho >> 7, hid = pn * 128 + (rho & 127);
            p0_tr_item(bj ? F.in[I_WU] : F.in[I_WG], DFF, 1024, (bf16_t*)(ws + WS_WGU), n0, hid, kb * 64, F.in[I_GFFN], scr, F.lane); continue; } r -= IT4;
        if (r < IT5) { p0_tr_item(F.in[I_WD], 1024, DFF, (bf16_t*)(ws + WS_WD), (r % 32) * 32, (r % 32) * 32, (r / 32) * 64, nullptr, scr, F.lane); continue; } r -= IT5;
        if (r < IT6) { p0_tr_item(F.in[I_WPG], 1024, 1024, (bf16_t*)(ws + WS_WPG), (r % 32) * 32, (r % 32) * 32, (r / 32) * 64, F.in[I_GPLE], scr, F.lane); continue; } r -= IT6;
        p0_tr_item(F.in[I_WPP], 1024, PLE, (bf16_t*)(ws + WS_WPP), (r % 32) * 32, (r % 32) * 32, (r / 32) * 64, nullptr, scr, F.lane);
    }
    __syncthreads();
    LAS float* wf = (LAS float*)F.lds;
    for (int idx = F.tid; idx < 2048; idx += NTHR) { const int k = idx >> 1, half = idx & 1;
        f32x4 w = *(const f32x4*)(F.in[I_WIN] + (size_t)k * INC + ZC_GA + 4 * half); const float gk = F.in[I_GMIX][k]; w = w * gk;
        const int l = (k & 255) >> 2, e = k & 3, j = k >> 8; *(LAS f32x4*)(wf + (((j * 4 + e) * 64 + l) * 8 + 4 * half)) = w; }
    __syncthreads();
    const float* x = F.in[I_X]; bf16_t* xb = (bf16_t*)(ws + WS_XB); float* rstd = (float*)(ws + WS_RSTD); float* lf = (float*)(ws + WS_LF);
    for (int mrow = gw; mrow < M; mrow += NGW) {
        const f32x4* xr = (const f32x4*)(x + (size_t)mrow * DMODEL) + F.lane;
        f32x4 v[4]; float ss = 0.f; float a[8];
#pragma unroll
        for (int h = 0; h < 8; ++h) a[h] = 0.f;
#pragma unroll
        for (int j = 0; j < 4; ++j) { v[j] = xr[64 * j]; ss += (v[j][0] * v[j][0] + v[j][1] * v[j][1]) + (v[j][2] * v[j][2] + v[j][3] * v[j][3]); }
#pragma unroll
        for (int j = 0; j < 4; ++j)
#pragma unroll
            for (int e = 0; e < 4; ++e) { const LAS f32x4* wp = (const LAS f32x4*)(wf + ((j * 4 + e) * 64 + F.lane) * 8); const f32x4 w0 = wp[0], w1 = wp[1]; const float xv = v[j][e];
#pragma unroll
                for (int h = 0; h < 4; ++h) { a[h] += xv * w0[h]; a[4 + h] += xv * w1[h]; } }
        ss = wave_sum(ss);
        const float rs = 1.0f / sqrtf(ss * (1.0f / DMODEL) + EPS);
#pragma unroll
        for (int h = 0; h < 8; ++h) a[h] = wave_sum(a[h]);
        unsigned long long* o8 = (unsigned long long*)(xb + (size_t)mrow * DMODEL) + F.lane;
#pragma unroll
        for (int j = 0; j < 4; ++j) o8[64 * j] = (unsigned long long)pk2(v[j][0], v[j][1]) | ((unsigned long long)pk2(v[j][2], v[j][3]) << 32);
        if (F.lane == 0) rstd[mrow] = rs;
        if (F.lane < 8) {
            float av = a[0];
#pragma unroll
            for (int h = 1; h < 8; ++h) av = (F.lane == h) ? a[h] : av;
            const float z = av * rs + F.in[I_FBIAS][F.lane];
            const int b = mrow >> 12, s = mrow & 4095;
            lf[(size_t)(b * 8 + F.lane) * SEQ + s] = log_sigmoid(z);
        }
    }
    { const float* p = F.in[I_P]; bf16_t* pb = (bf16_t*)(ws + WS_PB); const int gt = blockIdx.x * NTHR + F.tid, NT = F.G * NTHR;
      for (int i = gt; i < M * PLE / 8; i += NT) { const f32x4 a0 = *(const f32x4*)(p + (size_t)i * 8), a1 = *(const f32x4*)(p + (size_t)i * 8 + 4);
          u32x4 w; w.x = pk2(a0[0], a0[1]); w.y = pk2(a0[2], a0[3]); w.z = pk2(a1[0], a1[1]); w.w = pk2(a1[2], a1[3]); *(u32x4*)(pb + (size_t)i * 8) = w; } }
}

__device__ __forceinline__ void fox_scan(Frame& F) {
    if (blockIdx.x >= 64) return;
    const int bh = blockIdx.x; const float* lf = (const float*)(F.ws + WS_LF) + (size_t)bh * SEQ; double* cd = (double*)(F.ws + WS_CD) + (size_t)bh * SEQ;
    LAS double* wtot = (LAS double*)F.lds;
    double loc[8]; double run = 0.0;
    { const f32x4 a0 = *(const f32x4*)(lf + F.tid * 8), a1 = *(const f32x4*)(lf + F.tid * 8 + 4);
#pragma unroll
      for (int j = 0; j < 4; ++j) { run += (double)a0[j]; loc[j] = run; }
#pragma unroll
      for (int j = 0; j < 4; ++j) { run += (double)a1[j]; loc[4 + j] = run; } }
    double inc = run;
#pragma unroll
    for (int o = 1; o < 64; o <<= 1) { const double t = __shfl_up(inc, o); if (F.lane >= o) inc += t; }
    if (F.lane == 63) wtot[F.wave] = inc;
    __syncthreads();
    double base = inc - run;
    for (int w = 0; w < F.wave; ++w) base += wtot[w];
#pragma unroll
    for (int j = 0; j < 8; ++j) cd[F.tid * 8 + j] = base + loc[j];
    __syncthreads();
}

__device__ __forceinline__ void fox_naive(Frame& F) {
    bf16_t* Z = (bf16_t*)(F.ws + WS_Z); const double* cdall = (const double*)(F.ws + WS_CD);
    for (int u = blockIdx.x; u < 512; u += F.G) {
        const int bh = u >> 3, qblk = u & 7, b = bh >> 3, h = bh & 7, q = qblk * 512 + F.tid; const size_t row = (size_t)b * SEQ + q;
        const double* cd = cdall + (size_t)bh * SEQ;
        float qv[64], o[64];
#pragma unroll
        for (int c = 0; c < 8; ++c) { float t[8]; unpack8(*(const u32x4*)(Z + row * ZLD + ZC_FQ + h * 64 + c * 8), t);
#pragma unroll
            for (int j = 0; j < 8; ++j) { qv[c * 8 + j] = t[j]; o[c * 8 + j] = 0.f; } }
        const double cq = cd[q];
        float mx = -INFINITY, l = 0.f;
        const int kmax = qblk * 512 + (F.tid | 63);
        for (int k = 0; k <= kmax; ++k) {
            const size_t krow = (size_t)b * SEQ + k;
            float s = 0.f;
#pragma unroll
            for (int c = 0; c < 8; ++c) { float t[8]; unpack8(*(const u32x4*)(Z + krow * ZLD + ZC_FK + h * 64 + c * 8), t);
#pragma unroll
                for (int j = 0; j < 8; ++j) s += qv[c * 8 + j] * t[j]; }
            s += (float)((cq - cd[k]) * (double)LOG2E);
            if (k > q) s = -INFINITY;
            const float mn = fmaxf(mx, s); const float sc = exp2f(mx - mn), p = exp2f(s - mn);
            l = l * sc + p; mx = mn;
#pragma unroll
            for (int c = 0; c < 8; ++c) { float t[8]; unpack8(*(const u32x4*)(Z + krow * ZLD + ZC_FV + h * 64 + c * 8), t);
#pragma unroll
                for (int j = 0; j < 8; ++j) o[c * 8 + j] = o[c * 8 + j] * sc + p * t[j]; }
        }
        const float il = 1.0f / l;
#pragma unroll
        for (int c = 0; c < 8; ++c) { float t[8];
#pragma unroll
            for (int j = 0; j < 8; ++j) t[j] = o[c * 8 + j] * il;
            *(u32x4*)(Z + row * ZLD + ZC_FQ + h * 64 + c * 8) = pack8(t); }
    }
}
__device__ __forceinline__ void hgrn_naive_rec(Frame& F) {
    const bf16_t* Z = (const bf16_t*)(F.ws + WS_Z); float* OT = F.out;
    LAS float* red = (LAS float*)F.lds;
    for (int item = blockIdx.x; item < 256; item += F.G) {
        const int bh = item >> 3, vs = item & 7, b = bh >> 2, h = bh & 3, k = F.tid & 127, vq = F.tid >> 7;
        float S[4] = {0.f, 0.f, 0.f, 0.f};
        const bf16_t* zb = Z + (size_t)b * SEQ * ZLD;
        float qn = bf1(zb[ZC_Q + 128 * h + k]), lfn = bf1(zb[ZC_F + 128 * h + k]); u32x2 vn = *(const u32x2*)(zb + ZC_I + 128 * h + 16 * vs + 4 * vq);
        for (int t = 0; t < SEQ; ++t) {
            const float q = qn, lfv = lfn; const u32x2 vw = vn;
            if (t + 1 < SEQ) { const bf16_t* zr = zb + (size_t)(t + 1) * ZLD; qn = bf1(zr[ZC_Q + 128 * h + k]); lfn = bf1(zr[ZC_F + 128 * h + k]); vn = *(const u32x2*)(zr + ZC_I + 128 * h + 16 * vs + 4 * vq); }
            const float f = __expf(lfv), kf = 1.0f - f;
            const float v[4] = {bflo(vw.x), bfhi(vw.x), bflo(vw.y), bfhi(vw.y)};
            float po[4];
#pragma unroll
            for (int j = 0; j < 4; ++j) { S[j] = f * S[j] + kf * v[j]; po[j] = wave_sum(q * S[j]); }
            LAS float* rb = red + (t & 1) * 32;
            if (F.lane == 0) { rb[F.wave * 4 + 0] = po[0]; rb[F.wave * 4 + 1] = po[1]; rb[F.wave * 4 + 2] = po[2]; rb[F.wave * 4 + 3] = po[3]; }
            __syncthreads();
            if (F.tid < 16) { const int vq2 = F.tid >> 2, j = F.tid & 3; const float o = rb[(2 * vq2) * 4 + j] + rb[(2 * vq2 + 1) * 4 + j];
                OT[((size_t)b * SEQ + t) * 512 + 128 * h + 16 * vs + F.tid] = o; }
        }
        __syncthreads();
    }
}
__device__ __forceinline__ void hgrn_naive_norm(Frame& F) {
    bf16_t* Z = (bf16_t*)(F.ws + WS_Z); const float* OT = F.out; const float* og = F.in[I_ONG];
    const int gw = blockIdx.x * NWAVES + F.wave, NGW = F.G * NWAVES;
    for (int it = gw; it < M * 4; it += NGW) {
        const int row = it >> 2, h = it & 3;
        const f32x2 o = *(const f32x2*)(OT + (size_t)row * 512 + 128 * h + 2 * F.lane);
        const float ss = wave_sum(o[0] * o[0] + o[1] * o[1]);
        const float rs = 1.0f / sqrtf(ss * (1.0f / 128.0f) + EPS);
        const unsigned gw2 = *(const unsigned*)(Z + (size_t)row * ZLD + ZC_G + 128 * h + 2 * F.lane);
        const float y0 = o[0] * rs * og[2 * F.lane] * bflo(gw2), y1 = o[1] * rs * og[2 * F.lane + 1] * bfhi(gw2);
        *(unsigned*)(Z + (size_t)row * ZLD + ZC_I + 128 * h + 2 * F.lane) = pk2(y0, y1);
    }
}

template <class Epi> __device__ __forceinline__ void run_gemm(Frame& F, const pg8::Gemm& g, const Epi& E) {
    pg8::StaticOrder S; S.init(g.M, g.N, F.G, (int)blockIdx.x);
#if USE_FAST_GEMM
    pg8::gemm_phase<Epi, true, true>(F.lds, g, S, E);
#else
    pg8::gemm_naive<Epi>(g, S, E);
#endif
}

__global__ void __launch_bounds__(NTHR, 2) skel_fwd(Args args) {
    extern __shared__ __attribute__((aligned(16))) unsigned char lds[];
    Frame F;
    F.lds = (LAS unsigned char*)lds; F.tid = threadIdx.x; F.lane = F.tid & 63; F.wave = __builtin_amdgcn_readfirstlane(F.tid >> 6); F.G = gridDim.x;
#pragma unroll
    for (int i = 0; i < 19; ++i) F.in[i] = args.in[i];
    F.out = args.out; F.ws = args.ws;
    unsigned char* ws = args.ws;
    bf16_t* Z = (bf16_t*)(ws + WS_Z); bf16_t* XB = (bf16_t*)(ws + WS_XB);
    const int ph = args.ph;
#define IN(k) (ph < 0 || ph == (k))
#if ONE_LAUNCH
#define SEAM() cg::this_grid().sync()
#else
#define SEAM() do {} while (0)
#endif
    if (IN(0)) { p0_prologue(F); SEAM(); }
    if (IN(1)) {
        fox_scan(F);
        pg8::Gemm g{XB, (const bf16_t*)(ws + WS_WIN), M, ZLD, 1024, 1024};
        pg8::EpiIn E{Z, (const float*)(ws + WS_RSTD), F.in[I_LBL], F.in[I_QG], F.in[I_KG]};
        run_gemm(F, g, E); SEAM();
    }
    if (IN(2)) {
#if USE_FAST_MIX
#else
        if (ph < 0) { fox_naive(F); hgrn_naive_rec(F); SEAM(); hgrn_naive_norm(F); }
#endif
        SEAM();
    }
#if !USE_FAST_MIX
    if (ph == 8) fox_naive(F);
    if (ph == 9) hgrn_naive_rec(F);
    if (ph == 10) hgrn_naive_norm(F);
#endif
    if (IN(3)) {
        { pg8::Gemm g{Z + ZC_I, (const bf16_t*)(ws + WS_WA), M, 1024, 512, ZLD}; pg8::EpiGate E{XB, 1024, Z + ZC_GA, ZLD, false}; run_gemm(F, g, E); }
        { pg8::Gemm g{Z + ZC_FQ, (const bf16_t*)(ws + WS_WB), M, 1024, 512, ZLD}; pg8::EpiGate E{XB, 1024, Z + ZC_GB, ZLD, true}; run_gemm(F, g, E); }
        SEAM();
    }
    if (IN(4)) {
        pg8::Gemm g{XB, (const bf16_t*)(ws + WS_WOUT), M, 1024, 1024, 1024};
        pg8::EpiResid E{F.in[I_X], F.out, (bf16_t*)(ws + WS_X1B), (float*)(ws + WS_SSQ1)};
        run_gemm(F, g, E); SEAM();
    }
    if (IN(5)) {
        pg8::Gemm g{(const bf16_t*)(ws + WS_X1B), (const bf16_t*)(ws + WS_WGU), M, 2 * DFF, 1024, 1024};
        pg8::EpiSwiglu E{(bf16_t*)(ws + WS_H), (const float*)(ws + WS_SSQ1)};
        run_gemm(F, g, E); SEAM();
    }
    if (IN(6)) {
        pg8::Gemm g{(const bf16_t*)(ws + WS_H), (const bf16_t*)(ws + WS_WD), M, 1024, DFF, DFF};
        pg8::EpiResid E{F.out, F.out, XB, (float*)(ws + WS_SSQ2)};
        run_gemm(F, g, E); SEAM();
    }
    if (IN(7)) {
        { pg8::Gemm g{(const bf16_t*)(ws + WS_PB), (const bf16_t*)(ws + WS_WPP), M, 1024, PLE, PLE}; pg8::EpiPlain E{(bf16_t*)(ws + WS_PP), 1024}; run_gemm(F, g, E); }
        { pg8::Gemm g{XB, (const bf16_t*)(ws + WS_WPG), M, 1024, 1024, 1024}; pg8::EpiPle E{F.out, (const bf16_t*)(ws + WS_PP), (const float*)(ws + WS_SSQ2)}; run_gemm(F, g, E); }
    }
#undef IN
#undef SEAM
}

extern "C" void kernel_launch(void* const* d_in, const int* in_sizes, int n_in, void* d_out, int out_size, void* d_ws, size_t ws_size, hipStream_t stream) {
    static int grid = 0;
    if (grid == 0) {
        if (n_in != 19 || out_size != M * DMODEL || ws_size < WS_END) { fprintf(stderr, "kernel_launch: unexpected shapes (n_in %d out %d ws %zu)\n", n_in, out_size, ws_size); grid = -1; return; }
        int dev = 0, cus = 0, per_cu = 0;
        hipGetDevice(&dev); hipDeviceGetAttribute(&cus, hipDeviceAttributeMultiprocessorCount, dev);
        hipFuncSetAttribute((const void*)skel_fwd, hipFuncAttributeMaxDynamicSharedMemorySize, LDS_BYTES);
        hipOccupancyMaxActiveBlocksPerMultiprocessor(&per_cu, (const void*)skel_fwd, NTHR, LDS_BYTES);
        if (per_cu < 1) per_cu = 1;
        (void)hipGetLastError();
        grid = cus * per_cu;
    }
    if (grid < 0) return;
    hipMemsetAsync((char*)d_ws + WS_CTL, 0, CTL_ZERO_BYTES, stream);
    Args a{};
    for (int i = 0; i < 19; ++i) a.in[i] = (const float*)d_in[i];
    a.out = (float*)d_out; a.ws = (unsigned char*)d_ws;
#if ONE_LAUNCH
    a.ph = -1;
    void* kargs[] = {&a};
    hipError_t e = hipLaunchCooperativeKernel((const void*)skel_fwd, dim3(grid), dim3(NTHR), kargs, LDS_BYTES, stream);
    if (e != hipSuccess) fprintf(stderr, "cooperative launch failed: %s (grid %d)\n", hipGetErrorString(e), grid);
#else
#if USE_FAST_MIX
    const int phases[] = {0, 1, 2, 3, 4, 5, 6, 7};
#else
    const int phases[] = {0, 1, 8, 9, 10, 3, 4, 5, 6, 7};
#endif
    for (int ph : phases) { a.ph = ph; hipLaunchKernelGGL(skel_fwd, dim3(grid), dim3(NTHR), LDS_BYTES, stream, a); }
#endif
}
```

```cpp
#include <hip/hip_runtime.h>
#include <hip/hip_cooperative_groups.h>
#include <cstdio>
#include <cstdint>
#include <cmath>
namespace cg = cooperative_groups;

#ifndef ONE_LAUNCH
#define ONE_LAUNCH 1
#endif

#define GAS __attribute__((address_space(1)))
#define LAS __attribute__((address_space(3)))
typedef unsigned short bf16_t;
typedef short bf16x8 __attribute__((ext_vector_type(8)));
typedef float f32x4 __attribute__((ext_vector_type(4)));
typedef float f32x2 __attribute__((ext_vector_type(2)));
typedef unsigned u32x4 __attribute__((ext_vector_type(4)));
typedef unsigned u32x2 __attribute__((ext_vector_type(2)));

constexpr int BATCH = 8, SEQ = 4096, DMODEL = 1024, M = BATCH * SEQ;
constexpr int INC = 5640, ZLD = 5632, DFF = 2816, PLE = 256;
constexpr int ZC_Q = 0, ZC_F = 512, ZC_I = 1024, ZC_G = 1536, ZC_FQ = 2048, ZC_FK = 2560, ZC_FV = 3072, ZC_GA = 3584, ZC_GB = 4608;
constexpr float EPS = 1e-6f;
constexpr float LOG2E = 1.4426950408889634f;
constexpr float C2 = 0.125f * 1.4426950408889634f;
constexpr int NWAVES = 8, NTHR = 512;

constexpr size_t MiB = 1u << 20;
constexpr size_t WS_CTL = 0, CTL_ZERO_BYTES = 1 * MiB;
constexpr size_t WS_WIN = 1 * MiB, WS_WA = 12 * MiB, WS_WB = 13 * MiB, WS_WOUT = 14 * MiB, WS_WGU = 16 * MiB, WS_WD = 27 * MiB, WS_WPG = 33 * MiB, WS_WPP = 35 * MiB;
constexpr size_t WS_T0 = 35 * MiB + 768 * 1024;
constexpr size_t WS_RSTD = 36 * MiB, WS_LF = 36 * MiB + 256 * 1024, WS_CD = 38 * MiB, WS_SSQ1 = 40 * MiB, WS_SSQ2 = 42 * MiB;
constexpr size_t WS_XB = 44 * MiB, WS_PB = 108 * MiB, WS_Z = 124 * MiB;
constexpr size_t WS_HGU = 476 * MiB, WS_HGLB = 484 * MiB;
constexpr size_t WS_X1B = WS_Z, WS_H = WS_Z + 64 * MiB, WS_PP = WS_Z + 240 * MiB, WS_END = WS_Z + 352 * MiB;
static_assert(WS_END <= WS_HGU && WS_HGLB + 65536 <= 512 * MiB, "ws map");
constexpr int LDS_BYTES = 155648;

__device__ __forceinline__ unsigned f2bf(float f) { unsigned u = __builtin_bit_cast(unsigned, f); return (u + 0x7fffu + ((u >> 16) & 1u)) >> 16; }
__device__ __forceinline__ unsigned pk2(float lo, float hi) { typedef float f2_ __attribute__((ext_vector_type(2))); typedef __bf16 b2_ __attribute__((ext_vector_type(2))); f2_ v = {lo, hi}; b2_ b = __builtin_convertvector(v, b2_); return __builtin_bit_cast(unsigned, b); }
__device__ __forceinline__ float bflo(unsigned w) { return __builtin_bit_cast(float, w << 16); }
__device__ __forceinline__ float bfhi(unsigned w) { return __builtin_bit_cast(float, w & 0xffff0000u); }
__device__ __forceinline__ float bf1(bf16_t h) { return __builtin_bit_cast(float, (unsigned)h << 16); }
__device__ __forceinline__ float row16_sum(float v) {
    v += __builtin_bit_cast(float, __builtin_amdgcn_update_dpp(0, __builtin_bit_cast(int, v), 0x128, 0xf, 0xf, false));
    v += __builtin_bit_cast(float, __builtin_amdgcn_update_dpp(0, __builtin_bit_cast(int, v), 0x124, 0xf, 0xf, false));
    v += __builtin_bit_cast(float, __builtin_amdgcn_update_dpp(0, __builtin_bit_cast(int, v), 0x122, 0xf, 0xf, false));
    v += __builtin_bit_cast(float, __builtin_amdgcn_update_dpp(0, __builtin_bit_cast(int, v), 0x121, 0xf, 0xf, false));
    return v;
}
__device__ __forceinline__ float quad_sum(float v) {
    { const unsigned u = __builtin_bit_cast(unsigned, v); auto r = __builtin_amdgcn_permlane16_swap(u, u, false, false); v = __builtin_bit_cast(float, (unsigned)r[0]) + __builtin_bit_cast(float, (unsigned)r[1]); }
    { const unsigned u = __builtin_bit_cast(unsigned, v); auto r = __builtin_amdgcn_permlane32_swap(u, u, false, false); v = __builtin_bit_cast(float, (unsigned)r[0]) + __builtin_bit_cast(float, (unsigned)r[1]); }
    return v;
}
__device__ __forceinline__ float wave_sum(float v) {
    v = row16_sum(v);
    const int iv = __builtin_bit_cast(int, v);
    return (__builtin_bit_cast(float, __builtin_amdgcn_readlane(iv, 0)) + __builtin_bit_cast(float, __builtin_amdgcn_readlane(iv, 16))) +
           (__builtin_bit_cast(float, __builtin_amdgcn_readlane(iv, 32)) + __builtin_bit_cast(float, __builtin_amdgcn_readlane(iv, 48)));
}
__device__ __forceinline__ float sigmoidf_(float v) { return __builtin_amdgcn_rcpf(1.0f + __builtin_amdgcn_exp2f(-1.4426950408889634f * v)); }
__device__ __forceinline__ void unpack8(u32x4 w, float (&f)[8]) { f[0] = bflo(w.x); f[1] = bfhi(w.x); f[2] = bflo(w.y); f[3] = bfhi(w.y); f[4] = bflo(w.z); f[5] = bfhi(w.z); f[6] = bflo(w.w); f[7] = bfhi(w.w); }
__device__ __forceinline__ u32x4 pack8(const float (&f)[8]) { u32x4 w; w.x = pk2(f[0], f[1]); w.y = pk2(f[2], f[3]); w.z = pk2(f[4], f[5]); w.w = pk2(f[6], f[7]); return w; }
#define LDS_WAIT() asm volatile("s_waitcnt lgkmcnt(0)" ::: "memory")
__device__ __forceinline__ int fresh_tid(int wave_s) { unsigned z = 0u; asm volatile("" : "+v"(z)); int t = wave_s * 64 + (int)__builtin_amdgcn_mbcnt_hi(~0u, __builtin_amdgcn_mbcnt_lo(~0u, z)); asm volatile("" : "+v"(t)); return t; }

namespace pg8 {
constexpr int BM = 256, BK = 64, HALF = 128, HTB = HALF * BK * 2, STAGE_BYTES = 8 * HTB, NXCD = 8, WGM = 4;
__host__ __device__ __forceinline__ int lds_byte(int r, int c) { const int st = (r >> 4) * 2 + (c >> 5), rr = r & 15, cc = c & 31, ob = rr * 64 + cc * 2; return st * 1024 + (ob ^ (((ob >> 9) & 1) << 5)); }
__host__ __device__ __forceinline__ void stage_rc(int b, int& R, int& C) { const int st = b / 1024, sb = b % 1024, swz = sb ^ (((sb >> 9) & 1) << 5); R = (st >> 1) * 16 + swz / 64; C = (st & 1) * 32 + (swz % 64) / 2; }
__host__ __device__ __forceinline__ int perm32(int rho) { const int n = rho >> 4, i = rho & 15; return 8 * (i >> 2) + 4 * n + (i & 3); }
struct Unit { int pm, pn; };
struct Gemm { const bf16_t* A; const bf16_t* Bt; int M, N, K, lda; int ldb = 0; const bf16_t* A2 = nullptr; const bf16_t* Bt2 = nullptr; int khalf = 0; };
struct StaticOrder {
    int nM, nN, nwg, G, c;
    __host__ __device__ void init(int M_, int N_, int G_, int c_) { nM = M_ / BM; nN = N_ / BM; nwg = nM * nN; G = G_; c = c_; }
    __host__ __device__ bool next(int i, Unit& u) const {
        const long L = (long)i * G + c; if (L >= nwg) return false;
        int wgid = (int)L; { const int q = nwg / NXCD, r = nwg % NXCD, xcd = wgid % NXCD, off = wgid / NXCD; wgid = (xcd < r ? xcd * (q + 1) : r * (q + 1) + (xcd - r) * q) + off; }
        const int nig = WGM * nN, gid = wgid / nig, fm = gid * WGM, gsz = (nM - fm) < WGM ? (nM - fm) : WGM;
        u.pm = fm + ((wgid % nig) % gsz); u.pn = (wgid % nig) / gsz; return true;
    }
};
typedef f32x4 Acc[2][2][4][2];

template <class Epi, bool ALIGN_EPI = true, bool SP2 = true>
__device__ __forceinline__ void gemm_phase(int wave_s, LAS unsigned char* lds, const Gemm g, const StaticOrder& S, const Epi& E) {
    const int tid = fresh_tid(wave_s);
    const int wid = __builtin_amdgcn_readfirstlane(tid >> 6), lane = tid & 63, wr = wid >> 2, wc = wid & 3, fr = lane & 15, fq = lane >> 4;
    const int K = g.K, nt = K / BK, LDB = g.ldb ? g.ldb : K, kh = g.khalf ? g.khalf : nt;
    unsigned voffA[2], voffB[2];
#pragma unroll
    for (int i = 0; i < 2; ++i) { int R, C; stage_rc(tid * 16 + i * 8192, R, C); const int Rb = (R & ~31) + perm32(R & 31);
        voffA[i] = (unsigned)(R * g.lda + C) * 2u; voffB[i] = (unsigned)(Rb * LDB + C) * 2u; }
    const size_t kstep = (size_t)(BK * 2);
    const size_t hstepA = (size_t)HALF * g.lda * 2, hstepB = (size_t)HALF * LDB * 2;
    const size_t tstepA = 2 * hstepA, tstepB = 2 * hstepB;
    const unsigned ldsw = (unsigned)wid * 1024u;
    const int aoff = lds_byte(wr * 64 + fr, fq * 8), boff = lds_byte(wc * 32 + fr, fq * 8);
#define PG8_SA(b, h) (((b) * 2 + (h)) * HTB)
#define PG8_SB(b, h) ((4 + (b) * 2 + (h)) * HTB)
#define PG8_STAGE(bufoff, gbase, voff) do { _Pragma("unroll") for (int _i = 0; _i < 2; ++_i) \
        __builtin_amdgcn_global_load_lds((const unsigned*)((const char*)(gbase) + (voff)[_i]), (LAS unsigned*)(lds + (bufoff) + ldsw + _i * 8192), 16, 0, 0); } while (0)
#define PG8_LDA(dst, b, h) do { _Pragma("unroll") for (int m = 0; m < 4; ++m) _Pragma("unroll") for (int k = 0; k < 2; ++k) dst[m][k] = *(const LAS bf16x8*)(lds + PG8_SA(b, h) + aoff + m * 2048 + k * 1024); } while (0)
#define PG8_LDB(dst, b, h) do { _Pragma("unroll") for (int n = 0; n < 2; ++n) _Pragma("unroll") for (int k = 0; k < 2; ++k) dst[n][k] = *(const LAS bf16x8*)(lds + PG8_SB(b, h) + boff + n * 2048 + k * 1024); } while (0)
#define PG8_MMA(ai, bj, At, Bt) do { __builtin_amdgcn_s_setprio(1); _Pragma("unroll") for (int m = 0; m < 4; ++m) _Pragma("unroll") for (int n = 0; n < 2; ++n) _Pragma("unroll") for (int k = 0; k < 2; ++k) \
        acc[ai][bj][m][n] = __builtin_amdgcn_mfma_f32_16x16x32_bf16(Bt[n][k], At[m][k], acc[ai][bj][m][n], 0, 0, 0); __builtin_amdgcn_s_setprio(0); } while (0)
#define PG8_WAIT_V(n) asm volatile("s_waitcnt vmcnt(" #n ")" ::: "memory")
#define PG8_WAIT_L(n) asm volatile("s_waitcnt lgkmcnt(" #n ")" ::: "memory")
#define PG8_BAR __builtin_amdgcn_s_barrier()
#define PG8_SCHED __builtin_amdgcn_sched_barrier(0)
    Unit cur, nxt; int ui = 0;
    if (!S.next(0, cur)) return;
    Acc acc;
#pragma unroll
    for (int a = 0; a < 2; ++a)
#pragma unroll
        for (int b = 0; b < 2; ++b)
#pragma unroll
            for (int m = 0; m < 4; ++m)
#pragma unroll
                for (int n = 0; n < 2; ++n) acc[a][b][m][n] = (f32x4){0.f, 0.f, 0.f, 0.f};
    bf16x8 At[4][2], B0[2][2], B1[2][2];
    const char* cA = (const char*)g.A + (size_t)cur.pm * tstepA; const char* cB = (const char*)g.Bt + (size_t)cur.pn * tstepB;
    const char* sA2 = g.khalf ? (const char*)g.A2 : (const char*)g.A + (size_t)kh * kstep; const char* sB2 = g.khalf ? (const char*)g.Bt2 : (const char*)g.Bt + (size_t)kh * kstep;
    const char* cA2 = sA2 + (size_t)cur.pm * tstepA; const char* cB2 = sB2 + (size_t)cur.pn * tstepB;
#define PG8_TA(tt) ((tt) < kh ? cA + (size_t)(tt) * kstep : cA2 + (size_t)((tt) - kh) * kstep)
#define PG8_TB(tt) ((tt) < kh ? cB + (size_t)(tt) * kstep : cB2 + (size_t)((tt) - kh) * kstep)
    if constexpr (SP2) {
        PG8_STAGE(PG8_SB(0, 0), cB, voffB); PG8_STAGE(PG8_SB(0, 1), cB + hstepB, voffB); PG8_STAGE(PG8_SA(0, 0), cA, voffA); PG8_STAGE(PG8_SA(0, 1), cA + hstepA, voffA);
        if (wr == 1) PG8_BAR;
        PG8_WAIT_V(2); PG8_BAR;
        PG8_STAGE(PG8_SB(1, 0), cB + kstep, voffB); PG8_STAGE(PG8_SA(1, 0), cA + kstep, voffA); PG8_STAGE(PG8_SB(1, 1), cB + hstepB + kstep, voffB);
        PG8_WAIT_V(6); PG8_BAR;
    }
    for (;;) {
        const bool has_next = S.next(ui + 1, nxt);
        const char* nA = has_next ? (const char*)g.A + (size_t)nxt.pm * tstepA : cA; const char* nB = has_next ? (const char*)g.Bt + (size_t)nxt.pn * tstepB : cB;
        for (int t = 0; t < nt; t += 2) {
            const bool last = (t == nt - 2);
            const char* a1 = PG8_TA(t + 1);
            const char* a2 = last ? nA : PG8_TA(t + 2); const char* b2 = last ? nB : PG8_TB(t + 2);
            const char* a3 = last ? nA + kstep : PG8_TA(t + 3); const char* b3 = last ? nB + kstep : PG8_TB(t + 3);
            if constexpr (Epi::HAS_MID) { if (t == kh) E.mid(acc, cur, wr, wc, fr, fq); }
            PG8_LDB(B0, 0, 0); PG8_LDB(B1, 0, 1); PG8_SCHED; PG8_LDA(At, 0, 0); PG8_STAGE(PG8_SA(1, 1), a1 + hstepA, voffA);
            PG8_WAIT_V(8); PG8_WAIT_L(0); PG8_BAR; PG8_MMA(0, 0, At, B0); PG8_MMA(0, 1, At, B1); PG8_BAR; PG8_SCHED;
            PG8_LDA(At, 0, 1); PG8_STAGE(PG8_SB(0, 0), b2, voffB); PG8_STAGE(PG8_SB(0, 1), b2 + hstepB, voffB); PG8_STAGE(PG8_SA(0, 0), a2, voffA);
            PG8_WAIT_V(8); PG8_WAIT_L(0); PG8_BAR; PG8_MMA(1, 0, At, B0); PG8_MMA(1, 1, At, B1); PG8_BAR; PG8_SCHED;
            PG8_LDB(B0, 1, 0); PG8_LDB(B1, 1, 1); PG8_SCHED; PG8_LDA(At, 1, 0); PG8_STAGE(PG8_SA(0, 1), a2 + hstepA, voffA);
            PG8_WAIT_V(8); PG8_WAIT_L(0); PG8_BAR; PG8_MMA(0, 0, At, B0); PG8_MMA(0, 1, At, B1); PG8_BAR; PG8_SCHED;
            PG8_LDA(At, 1, 1); PG8_STAGE(PG8_SB(1, 0), b3, voffB); PG8_STAGE(PG8_SB(1, 1), b3 + hstepB, voffB); PG8_STAGE(PG8_SA(1, 0), a3, voffA);
            PG8_WAIT_V(8); PG8_WAIT_L(0); PG8_BAR; PG8_MMA(1, 0, At, B0); PG8_MMA(1, 1, At, B1); PG8_BAR; PG8_SCHED;
        }
        if constexpr (ALIGN_EPI) { if (wr == 0) PG8_BAR; }
        E(acc, cur, wr, wc, fr, fq);
        if (!has_next) break;
#pragma unroll
        for (int a = 0; a < 2; ++a)
#pragma unroll
            for (int b = 0; b < 2; ++b)
#pragma unroll
                for (int m = 0; m < 4; ++m)
#pragma unroll
                    for (int n = 0; n < 2; ++n) acc[a][b][m][n] = (f32x4){0.f, 0.f, 0.f, 0.f};
        cur = nxt; cA = nA; cB = nB; cA2 = sA2 + (size_t)cur.pm * tstepA; cB2 = sB2 + (size_t)cur.pn * tstepB; ++ui;
        if constexpr (ALIGN_EPI) { if (wr == 1) PG8_BAR; }
    }
    PG8_WAIT_V(0);
    if constexpr (!ALIGN_EPI) { if (wr == 0) PG8_BAR; }
    PG8_BAR;
#undef PG8_SA
#undef PG8_SB
#undef PG8_TA
#undef PG8_TB
#undef PG8_STAGE
#undef PG8_LDA
#undef PG8_LDB
#undef PG8_MMA
#undef PG8_WAIT_V
#undef PG8_WAIT_L
#undef PG8_BAR
#undef PG8_SCHED
}

__device__ __forceinline__ void get8(const Acc& acc, int ai, int bj, int m, float (&v)[8]) {
#pragma unroll
    for (int e = 0; e < 4; ++e) { v[e] = acc[ai][bj][m][0][e]; v[4 + e] = acc[ai][bj][m][1][e]; }
}

struct EpiIn {
    static constexpr bool HAS_MID = false;
    bf16_t* Z; const float* rstd; const float* lbl; const float* qg; const float* kg;
    template <int MODE> __device__ __forceinline__ void run(const Acc& acc, const Unit& u, int wr, int wc, int fr, int fq) const {
        constexpr bool HP = (MODE == 3 || MODE == 4);
        int colb[2];
#pragma unroll
        for (int bj = 0; bj < 2; ++bj) colb[bj] = HP ? (u.pn * 256 + 64 * wc + 32 * bj + 8 * fq) : (u.pn * 256 + 128 * bj + 32 * wc + 8 * fq);
        float aux[2][8];
#pragma unroll
        for (int bj = 0; bj < 2; ++bj)
#pragma unroll
            for (int j = 0; j < 8; ++j) {
                if (MODE == 1) { const int k = colb[bj] - ZC_F + j; const float l0 = lbl[k], l1 = lbl[512 + k]; aux[bj][j] = sigmoidf_(l0 - l1); }
                else if (MODE == 3) aux[bj][j] = qg[(colb[bj] + j) & 63] * C2;
                else if (MODE == 4) aux[bj][j] = kg[(colb[bj] + j) & 63];
                else aux[bj][j] = 0.f;
            }
        float one = 1.0f; asm volatile("" : "+v"(one));
#pragma unroll
        for (int ai = 0; ai < 2; ++ai) {
#pragma unroll
            for (int m = 0; m < 4; ++m) {
                const int row = u.pm * 256 + ai * 128 + wr * 64 + m * 16 + fr;
                float v[2][8];
#pragma unroll
                for (int bj = 0; bj < 2; ++bj) { get8(acc, ai, bj, m, v[bj]);
#pragma unroll
                    for (int j = 0; j < 8; ++j) v[bj][j] *= one; }
                if (HP) {
                    float ss = 0.f;
#pragma unroll
                    for (int bj = 0; bj < 2; ++bj)
#pragma unroll
                        for (int j = 0; j < 8; ++j) ss += v[bj][j] * v[bj][j];
                    ss = quad_sum(ss);
                    const float rn = __builtin_amdgcn_rsqf(ss * (1.0f / 64.0f) + EPS);
#pragma unroll
                    for (int bj = 0; bj < 2; ++bj)
#pragma unroll
                        for (int j = 0; j < 8; ++j) v[bj][j] = v[bj][j] * rn * aux[bj][j];
                }
#pragma unroll
                for (int bj = 0; bj < 2; ++bj) {
#pragma unroll
                    for (int j = 0; j < 8; ++j) {
                        float x = v[bj][j];
                        if (MODE == 0) x = x * sigmoidf_(x);
                        else if (MODE == 1) { const float lb = aux[bj][j]; const float fg = lb + (1.0f - lb) * sigmoidf_(x); x = 0.6931471805599453f * __builtin_amdgcn_logf(fg); }
                        else if (MODE == 5) x = sigmoidf_(x);
                        v[bj][j] = x;
                    }
                    *(u32x4*)(Z + (size_t)row * ZLD + colb[bj]) = pack8(v[bj]);
                }
                __builtin_amdgcn_sched_barrier(0);
            }
        }
    }
    __device__ __forceinline__ void operator()(const Acc& acc, const Unit& u, int wr, int wc, int fr, int fq) const {
        const int pn = u.pn;
        if (pn < 2) run<0>(acc, u, wr, wc, fr, fq);
        else if (pn < 4) run<1>(acc, u, wr, wc, fr, fq);
        else if (pn < 6) run<2>(acc, u, wr, wc, fr, fq);
        else if (pn < 8) run<0>(acc, u, wr, wc, fr, fq);
        else if (pn < 10) run<3>(acc, u, wr, wc, fr, fq);
        else if (pn < 12) run<4>(acc, u, wr, wc, fr, fq);
        else if (pn < 14) run<2>(acc, u, wr, wc, fr, fq);
        else run<5>(acc, u, wr, wc, fr, fq);
    }
};

struct EpiGate {
    static constexpr bool HAS_MID = true;
    bf16_t* out; int ldo; const bf16_t* ga; const bf16_t* gb; int ldg;
    __device__ __forceinline__ void mid(Acc& acc, const Unit& u, int wr, int wc, int fr_, int fq) const {
        int fr = fr_; asm volatile("" : "+v"(fr));
#pragma unroll
        for (int ai = 0; ai < 2; ++ai)
#pragma unroll
            for (int m = 0; m < 4; ++m) {
                u32x4 aw[2], bw[2];
#pragma unroll
                for (int bj = 0; bj < 2; ++bj) { const size_t off = (size_t)(u.pm * 256 + ai * 128 + wr * 64 + m * 16 + fr) * ldg + u.pn * 256 + 128 * bj + 32 * wc + 8 * fq;
                    aw[bj] = *(const u32x4*)(ga + off); bw[bj] = *(const u32x4*)(gb + off); }
                if (m & 1) __builtin_amdgcn_sched_barrier(0);
#pragma unroll
                for (int bj = 0; bj < 2; ++bj) { float a8[8], b8[8]; unpack8(aw[bj], a8); unpack8(bw[bj], b8);
#pragma unroll
                    for (int e = 0; e < 4; ++e) { acc[ai][bj][m][0][e] *= b8[e] * __builtin_amdgcn_rcpf(a8[e]); acc[ai][bj][m][1][e] *= b8[4 + e] * __builtin_amdgcn_rcpf(a8[4 + e]); } }
            }
    }
    __device__ __forceinline__ void operator()(const Acc& acc, const Unit& u, int wr, int wc, int fr, int fq) const {
#pragma unroll
        for (int ai = 0; ai < 2; ++ai) {
            u32x4 gw[4][2];
#pragma unroll
            for (int m = 0; m < 4; ++m)
#pragma unroll
                for (int bj = 0; bj < 2; ++bj) gw[m][bj] = *(const u32x4*)(ga + (size_t)(u.pm * 256 + ai * 128 + wr * 64 + m * 16 + fr) * ldg + u.pn * 256 + 128 * bj + 32 * wc + 8 * fq);
            __builtin_amdgcn_sched_barrier(0);
#pragma unroll
            for (int m = 0; m < 4; ++m)
#pragma unroll
                for (int bj = 0; bj < 2; ++bj) { const int row = u.pm * 256 + ai * 128 + wr * 64 + m * 16 + fr, col = u.pn * 256 + 128 * bj + 32 * wc + 8 * fq;
                    float v[8], gt[8]; get8(acc, ai, bj, m, v); unpack8(gw[m][bj], gt);
#pragma unroll
                    for (int j = 0; j < 8; ++j) v[j] = gt[j] * v[j];
                    *(u32x4*)(out + (size_t)row * ldo + col) = pack8(v); }
            __builtin_amdgcn_sched_barrier(0);
        }
    }
};

template <bool BF16IN> struct EpiResid {
    static constexpr bool HAS_MID = false;
    const float* xin; const bf16_t* xinb; bf16_t* xb; float* ssq;
    __device__ __forceinline__ void operator()(const Acc& acc, const Unit& u, int wr, int wc, int fr, int fq) const {
#pragma unroll
        for (int ai = 0; ai < 2; ++ai)
#pragma unroll
            for (int mh = 0; mh < 2; ++mh) {
                f32x4 x0[2][2], x1[2][2]; u32x4 xw[2][2];
#pragma unroll
                for (int m2 = 0; m2 < 2; ++m2)
#pragma unroll
                    for (int bj = 0; bj < 2; ++bj) { const size_t off = (size_t)(u.pm * 256 + ai * 128 + wr * 64 + (2 * mh + m2) * 16 + fr) * DMODEL + u.pn * 256 + 128 * bj + 32 * wc + 8 * fq;
                        if constexpr (BF16IN) xw[m2][bj] = *(const u32x4*)(xinb + off); else { x0[m2][bj] = *(const f32x4*)(xin + off); x1[m2][bj] = *(const f32x4*)(xin + off + 4); } }
                __builtin_amdgcn_sched_barrier(0);
#pragma unroll
                for (int m2 = 0; m2 < 2; ++m2) {
                    const int m = 2 * mh + m2;
                    const int row = u.pm * 256 + ai * 128 + wr * 64 + m * 16 + fr;
                    float ss = 0.f;
#pragma unroll
                    for (int bj = 0; bj < 2; ++bj) {
                        const size_t off = (size_t)row * DMODEL + u.pn * 256 + 128 * bj + 32 * wc + 8 * fq;
                        float v[8], xr[8]; get8(acc, ai, bj, m, v);
                        if constexpr (BF16IN) unpack8(xw[m2][bj], xr);
                        else {
#pragma unroll
                            for (int j = 0; j < 4; ++j) { xr[j] = x0[m2][bj][j]; xr[4 + j] = x1[m2][bj][j]; } }
#pragma unroll
                        for (int j = 0; j < 8; ++j) { v[j] += xr[j]; ss += v[j] * v[j]; }
                        *(u32x4*)(xb + off) = pack8(v);
                    }
                    ss = quad_sum(ss);
                    if (fq == 0) ssq[(size_t)row * 16 + u.pn * 4 + wc] = ss;
                }
                __builtin_amdgcn_sched_barrier(0);
            }
    }
};
__device__ __forceinline__ void rstd8_from_ssq(const float* ssq, const Unit& u, int wr, int fr, int fq, float (&rs)[2][4]) {
    f32x4 sq[2][4];
#pragma unroll
    for (int ai = 0; ai < 2; ++ai)
#pragma unroll
        for (int m = 0; m < 4; ++m) sq[ai][m] = *(const f32x4*)(ssq + (size_t)(u.pm * 256 + ai * 128 + wr * 64 + m * 16 + fr) * 16 + 4 * fq);
    __builtin_amdgcn_sched_barrier(0);
    float p[2][4];
#pragma unroll
    for (int ai = 0; ai < 2; ++ai)
#pragma unroll
        for (int m = 0; m < 4; ++m) p[ai][m] = (sq[ai][m][0] + sq[ai][m][1]) + (sq[ai][m][2] + sq[ai][m][3]);
#pragma unroll
    for (int ai = 0; ai < 2; ++ai)
#pragma unroll
        for (int m = 0; m < 4; ++m) p[ai][m] = quad_sum(p[ai][m]);
#pragma unroll
    for (int ai = 0; ai < 2; ++ai)
#pragma unroll
        for (int m = 0; m < 4; ++m) rs[ai][m] = __builtin_amdgcn_rsqf(p[ai][m] * (1.0f / DMODEL) + EPS);
}
__device__ __forceinline__ float rstd_from_ssq(const float* ssq, int row) {
    const f32x4* p = (const f32x4*)(ssq + (size_t)row * 16);
    const f32x4 a = p[0], b = p[1], c = p[2], d = p[3];
    const float s = ((a[0] + a[1]) + (a[2] + a[3])) + ((b[0] + b[1]) + (b[2] + b[3])) + ((c[0] + c[1]) + (c[2] + c[3])) + ((d[0] + d[1]) + (d[2] + d[3]));
    return 1.0f / sqrtf(s * (1.0f / DMODEL) + EPS);
}
struct EpiSwiglu {
    static constexpr bool HAS_MID = false;
    bf16_t* H; const float* ssq;
    __device__ __forceinline__ void operator()(const Acc& acc, const Unit& u, int wr, int wc, int fr, int fq) const {
        float rsv[2][4]; rstd8_from_ssq(ssq, u, wr, fr, fq, rsv);
#pragma unroll
        for (int ai = 0; ai < 2; ++ai)
#pragma unroll
            for (int m = 0; m < 4; ++m) {
                const int row = u.pm * 256 + ai * 128 + wr * 64 + m * 16 + fr;
                const float rs = rsv[ai][m];
                float gv[8], uv[8]; get8(acc, ai, 0, m, gv); get8(acc, ai, 1, m, uv);
#pragma unroll
                for (int j = 0; j < 8; ++j) { const float gg = gv[j] * rs; gv[j] = gg * sigmoidf_(gg) * (uv[j] * rs); }
                *(u32x4*)(H + (size_t)row * DFF + u.pn * 128 + 32 * wc + 8 * fq) = pack8(gv);
            }
    }
};
struct EpiPlain {
    static constexpr bool HAS_MID = false;
    bf16_t* out; int ldo;
    __device__ __forceinline__ void operator()(const Acc& acc, const Unit& u, int wr, int wc, int fr, int fq) const {
#pragma unroll
        for (int ai = 0; ai < 2; ++ai)
#pragma unroll
            for (int m = 0; m < 4; ++m) {
                const int row = u.pm * 256 + ai * 128 + wr * 64 + m * 16 + fr;
#pragma unroll
                for (int bj = 0; bj < 2; ++bj) { float v[8]; get8(acc, ai, bj, m, v); *(u32x4*)(out + (size_t)row * ldo + u.pn * 256 + 128 * bj + 32 * wc + 8 * fq) = pack8(v); }
            }
    }
};
struct EpiPle {
    static constexpr bool HAS_MID = false;
    float* out; const bf16_t* x2b; const bf16_t* pp; const float* ssq;
    __device__ __forceinline__ void operator()(const Acc& acc, const Unit& u, int wr, int wc, int fr, int fq) const {
        float rsv[2][4]; rstd8_from_ssq(ssq, u, wr, fr, fq, rsv);
#pragma unroll
        for (int ai = 0; ai < 2; ++ai) {
            u32x4 xw[4][2], pw[4][2];
#pragma unroll
            for (int m = 0; m < 4; ++m)
#pragma unroll
                for (int bj = 0; bj < 2; ++bj) { const size_t off = (size_t)(u.pm * 256 + ai * 128 + wr * 64 + m * 16 + fr) * DMODEL + u.pn * 256 + 128 * bj + 32 * wc + 8 * fq;
                    xw[m][bj] = *(const u32x4*)(x2b + off); pw[m][bj] = *(const u32x4*)(pp + off); }
            __builtin_amdgcn_sched_barrier(0);
#pragma unroll
            for (int m = 0; m < 4; ++m) {
                const float rs = rsv[ai][m];
#pragma unroll
                for (int bj = 0; bj < 2; ++bj) {
                    const size_t off = (size_t)(u.pm * 256 + ai * 128 + wr * 64 + m * 16 + fr) * DMODEL + u.pn * 256 + 128 * bj + 32 * wc + 8 * fq;
                    float v[8], pv[8], xr[8]; get8(acc, ai, bj, m, v); unpack8(pw[m][bj], pv); unpack8(xw[m][bj], xr);
#pragma unroll
                    for (int j = 0; j < 8; ++j) v[j] = xr[j] + sigmoidf_(v[j] * rs) * pv[j];
                    *(f32x4*)(out + off) = (f32x4){v[0], v[1], v[2], v[3]}; *(f32x4*)(out + off + 4) = (f32x4){v[4], v[5], v[6], v[7]};
                }
            }
            __builtin_amdgcn_sched_barrier(0);
        }
    }
};
}

#include <hip/hip_bf16.h>
#include <cmath>
namespace attn_body {
using bf16=__hip_bfloat16;
using bf16x8=__attribute__((ext_vector_type(8)))short;
using s16x4=__attribute__((ext_vector_type(4)))short;
using f32x16=__attribute__((ext_vector_type(16)))float;
using u32x4=__attribute__((ext_vector_type(4)))unsigned;
constexpr int BATCH=8,NHEAD=8,SEQ=4096,D=64,DM=5632;
constexpr int NW=8,QBLK=32,QB=QBLK*NW,KVBLK=64,NQB=SEQ/QB;
constexpr int ATTN_PITCH=DM, ATTN_UNIT_ROWS=QB;
__device__ __forceinline__ int crow(int r,int hi){return (r&3)+8*(r>>2)+4*hi;}
#define SBAR() __builtin_amdgcn_sched_barrier(0)
__device__ __forceinline__ void cmask(f32x16&p0,f32x16&p1,int jb,int qrel,int hi){
  const float NEG=-INFINITY; int kb=64*jb+4*hi;
  #pragma unroll
  for(int r=0;r<16;++r){int kv=kb+(r&3)+8*(r>>2); if(kv>qrel)p0[r]=NEG; if(kv+32>qrel)p1[r]=NEG;}
}

constexpr int NSLOT=3, SLOTB=8192;
constexpr int LDS_K=0, LDS_V=NSLOT*SLOTB, LDS_WS=2*NSLOT*SLOTB, LDS_OST=LDS_WS+NW*64*4, LDS_BYTES=LDS_OST+NW*4096, LDS_CB=LDS_BYTES, LDS_CQ=LDS_CB+32768, LDS_TOTAL=LDS_CQ+NW*128;
constexpr float C2=0.125f*1.4426950408889634f;
__device__ __forceinline__ void glds16(const void*gsrc,unsigned lds_dst){unsigned keep;
  asm volatile("s_mov_b32 %0, m0\n\ts_mov_b32 m0, %2\n\ts_nop 0\n\tglobal_load_lds_dwordx4 %1, off\n\ts_mov_b32 m0, %0":"=&s"(keep):"v"(gsrc),"s"(lds_dst):"memory");}
__device__ __forceinline__ float max3f(float a,float b,float c){float r;asm("v_max3_f32 %0, %1, %2, %3":"=v"(r):"v"(a),"v"(b),"v"(c));return r;}
__device__ __forceinline__ float max2f(float a,float b){float r;asm("v_max_f32_e32 %0, %1, %2":"=v"(r):"v"(a),"v"(b));return r;}
__device__ __forceinline__ float fadd_s(float a,float b){float r;asm("v_add_f32_e32 %0, %1, %2":"=v"(r):"v"(a),"v"(b));return r;}
__device__ __forceinline__ float fsub_s(float a,float b){float r;asm("v_sub_f32_e32 %0, %1, %2":"=v"(r):"v"(a),"v"(b));return r;}
typedef float f32x2_t __attribute__((ext_vector_type(2))); typedef unsigned u32x2v __attribute__((ext_vector_type(2))); typedef __bf16 bf16x2_t __attribute__((ext_vector_type(2)));
__device__ __forceinline__ unsigned cvtpk_s(float lo,float hi){f32x2_t v={lo,hi};bf16x2_t b=__builtin_convertvector(v,bf16x2_t);return __builtin_bit_cast(unsigned,b);}
#define WAIT_BAR(N) asm volatile("s_waitcnt vmcnt(" #N ") lgkmcnt(0)\n\ts_barrier":::"memory")

__device__ __forceinline__ void qkt(f32x16&p0,f32x16&p1,const char*Kslot,const bf16x8*qr,int r32,int hi,bf16x8 kb0,bf16x8 kb1,bf16x8 qone){
  const char*kb=Kslot+hi*1024+r32*16;
  #pragma unroll
  for(int d0=0;d0<4;++d0){
    const bf16x8 b0=*reinterpret_cast<const bf16x8*>(kb+d0*2048);
    const bf16x8 b1=*reinterpret_cast<const bf16x8*>(kb+d0*2048+512);
    if(d0==0){p0=__builtin_amdgcn_mfma_f32_32x32x16_bf16(kb0,qone,f32x16{},0,0,0);p1=__builtin_amdgcn_mfma_f32_32x32x16_bf16(kb1,qone,f32x16{},0,0,0);}
    p0=__builtin_amdgcn_mfma_f32_32x32x16_bf16(b0,qr[d0],p0,0,0,0);p1=__builtin_amdgcn_mfma_f32_32x32x16_bf16(b1,qr[d0],p1,0,0,0);}
}
typedef __attribute__((address_space(3))) const char* lds_cptr;
typedef short v4i16_t __attribute__((ext_vector_type(4)));
__device__ __forceinline__ void kload8(bf16x8*kf,lds_cptr kp){
  kf[0]=*(const __attribute__((address_space(3))) bf16x8*)(kp);      kf[1]=*(const __attribute__((address_space(3))) bf16x8*)(kp+512);
  kf[2]=*(const __attribute__((address_space(3))) bf16x8*)(kp+2048); kf[3]=*(const __attribute__((address_space(3))) bf16x8*)(kp+2560);
  kf[4]=*(const __attribute__((address_space(3))) bf16x8*)(kp+4096); kf[5]=*(const __attribute__((address_space(3))) bf16x8*)(kp+4608);
  kf[6]=*(const __attribute__((address_space(3))) bf16x8*)(kp+6144); kf[7]=*(const __attribute__((address_space(3))) bf16x8*)(kp+6656);
}
__device__ __forceinline__ void kload2(bf16x8*kf,lds_cptr kp,int j){ kf[2*j]=*(const __attribute__((address_space(3))) bf16x8*)(kp+j*2048); kf[2*j+1]=*(const __attribute__((address_space(3))) bf16x8*)(kp+j*2048+512); }
__device__ __forceinline__ s16x4 vtr(lds_cptr p){ return __builtin_bit_cast(s16x4,__builtin_amdgcn_ds_read_tr16_b64_v4i16((__attribute__((address_space(3))) v4i16_t*)p)); }
__device__ __forceinline__ float rowmax(const f32x16&p0,const f32x16&p1){
  float a=max3f(p0[0],p0[1],p1[0]),b=max3f(p0[2],p0[3],p1[1]);a=max3f(a,p1[2],p1[3]);
  #pragma unroll
  for(int r=4;r<16;r+=4){a=max3f(a,p0[r],p0[r+1]);b=max3f(b,p0[r+2],p0[r+3]);a=max3f(a,p1[r],p1[r+1]);b=max3f(b,p1[r+2],p1[r+3]);}
  const float m=max2f(a,b);
  auto rr=__builtin_amdgcn_permlane32_swap(__float_as_uint(m),__float_as_uint(m),false,false);
  return max2f(__uint_as_float(rr[0]),__uint_as_float(rr[1]));
}
__device__ __forceinline__ void pv(f32x16*o,int vb,bf16x8 pa0,bf16x8 pa1,bf16x8 pa2,bf16x8 pa3){
  #pragma unroll
  for(int d0=0;d0<2;++d0){s16x4 lo[4],hi[4];
    #pragma unroll
    for(int ks=0;ks<4;++ks){
      asm volatile("ds_read_b64_tr_b16 %0,%1 offset:%c2":"=&v"(lo[ks]):"v"(vb),"i"(d0*4096+ks*1024):"memory");
      asm volatile("ds_read_b64_tr_b16 %0,%1 offset:%c2":"=&v"(hi[ks]):"v"(vb),"i"(d0*4096+ks*1024+512):"memory");}
    asm volatile("s_waitcnt lgkmcnt(0)":::"memory");SBAR();
    #define PK(k) (bf16x8){lo[k][0],lo[k][1],lo[k][2],lo[k][3],hi[k][0],hi[k][1],hi[k][2],hi[k][3]}
    o[d0]=__builtin_amdgcn_mfma_f32_32x32x16_bf16(pa0,PK(0),o[d0],0,0,0);
    o[d0]=__builtin_amdgcn_mfma_f32_32x32x16_bf16(pa1,PK(1),o[d0],0,0,0);
    o[d0]=__builtin_amdgcn_mfma_f32_32x32x16_bf16(pa2,PK(2),o[d0],0,0,0);
    o[d0]=__builtin_amdgcn_mfma_f32_32x32x16_bf16(pa3,PK(3),o[d0],0,0,0);
    #undef PK
  }
}

#ifndef ATTN_STORE16
#define ATTN_STORE16(p,v) (*(u32x4*)(p)=(v))
#endif
template<int THRL> __device__ __forceinline__ void attn_unit(int wave_s,bool dostore,int b,int h,int qb,int t0,const double*cdh,const bf16*Q,const bf16*__restrict__ K,const bf16*__restrict__ V,bf16*O,char*shm){
  const int tid=fresh_tid(wave_s); const int lane=tid&63,r32=lane&31,hi=lane>>5; const int wid=__builtin_amdgcn_readfirstlane(tid>>6);
  const long rowbase=(long)b*SEQ; const int q0=qb*QB;
  const bf16*Qw=Q+(rowbase+q0+wid*QBLK)*DM+h*D;
  const bf16*Kh=K+(rowbase+t0*KVBLK)*DM+h*D,*Vh=V+(rowbase+t0*KVBLK)*DM+h*D;
  const unsigned lds0=(unsigned)(uintptr_t)shm;
  float*wsf=(float*)(shm+LDS_WS)+wid*64;
  const bf16*ksrc=Kh+(long)lane*DM+wid*8;
  const bf16*vsrc=Vh+(long)(16*(wid&3)+(lane>>2))*DM+(wid>>2)*32+(lane&3)*8;
  const unsigned kdst=lds0+LDS_K+wid*1024, vdst=lds0+LDS_V+wid*1024;
  #define DMA_K(t,slot) glds16(ksrc+(long)(t)*KVBLK*DM,(unsigned)__builtin_amdgcn_readfirstlane(kdst+(slot)))
  #define DMA_V(t,slot) glds16(vsrc+(long)(t)*KVBLK*DM,(unsigned)__builtin_amdgcn_readfirstlane(vdst+(slot)))
  const char*Kbase=shm+LDS_K; bf16x8 kf[8];
  const lds_cptr shm3=(lds_cptr)shm; const lds_cptr kp0=shm3+LDS_K+hi*1024+r32*16; const lds_cptr vp0=shm3+LDS_V+((lane>>4)&1)*32+(lane&3)*8+(4*hi+((lane&15)>>2))*64;
  const int NT=(q0+QB)/KVBLK-t0;
  const lds_cptr cbp=shm3+LDS_CB+r32*8; float cq; float*cqs=(float*)(shm+LDS_CQ)+wid*32+r32;
  DMA_K(0,0);DMA_V(0,0);DMA_K(1,SLOTB);
  { const double c0=cdh[q0]; const int nk=q0+QB-t0*KVBLK; const double*cs=cdh+t0*KVBLK;
    double cv[8]; const double cqd=cdh[q0+wid*QBLK+r32];
    #pragma unroll
    for(int j=0;j<8;++j){ const int i=tid+j*NW*64; cv[j]=cs[i<nk?i:nk-1]; }
    #pragma unroll
    for(int j=0;j<8;++j){ const int i=tid+j*NW*64; if(i<nk){ const float kbv=(float)((c0-cv[j])*1.4426950408889634);
      const unsigned uh=__float_as_uint(kbv)&0xffff0000u; const float r1=kbv-__uint_as_float(uh);
      const unsigned um=__float_as_uint(r1)&0xffff0000u; const float r2=r1-__uint_as_float(um);
      const unsigned ul=__float_as_uint(r2)&0xffff0000u;
      *(__attribute__((address_space(3))) u32x2v*)((__attribute__((address_space(3))) char*)(shm3+LDS_CB)+i*8)=(u32x2v){(uh>>16)|um,(ul>>16)|0x3F800000u}; } }
    cq=(float)((cqd-c0)*1.4426950408889634); if(hi==0)*cqs=cq; }
  u32x4 qb4=(u32x4){hi?0u:0x3F803F80u,0u,0u,0u};
  #define SETNEG(val) do{ const float nv_=(val); const unsigned nh_=__float_as_uint(nv_)&0xffff0000u; const float n1_=nv_-__uint_as_float(nh_); \
    const unsigned nm_=__float_as_uint(n1_)&0xffff0000u; const float n2_=n1_-__uint_as_float(nm_); const unsigned nl_=__float_as_uint(n2_)&0xffff0000u; \
    qb4[1]=hi?0u:(0x3F80u|nh_); qb4[2]=hi?0u:((nm_>>16)|nl_); }while(0)
  #define qone __builtin_bit_cast(bf16x8,qb4)
  u32x2v kbn0,kbn1;
  #define KBLD(t) do{ kbn0=*(const __attribute__((address_space(3))) u32x2v*)(cbp+(t)*512); kbn1=*(const __attribute__((address_space(3))) u32x2v*)(cbp+(t)*512+256); }while(0)
  #define KBF(x) __builtin_bit_cast(bf16x8,(u32x4){x[0],x[1],0x3F803F80u,0u})
  bf16x8 qr[4];
  #pragma unroll
  for(int d0=0;d0<4;++d0)qr[d0]=*reinterpret_cast<const bf16x8*>(&Qw[(long)r32*DM+d0*16+hi*8]);
  float mhat=0.f,l_reg=0.f;f32x16 o[2];o[0]=f32x16{};o[1]=f32x16{};SETNEG(cq);
  const int qrel=wid*QBLK+r32;
  #define CMASK(P0,P1,t) do{int jb_=(t)-(NT-4); if(jb_>=0)cmask(P0,P1,jb_,qrel,hi);}while(0)
  bool resc=false;
  #define START(P0,P1) do{ const float rm=rowmax(P0,P1); resc=false; \
    { const float dl=rm; mhat=fadd_s(mhat,dl); \
      _Pragma("unroll") for(int r=0;r<16;++r){P0[r]=fsub_s(P0[r],dl);P1[r]=fsub_s(P1[r],dl);} \
      SETNEG(*cqs-mhat); } \
    _Pragma("unroll") for(int r=0;r<16;++r)P0[r]=__builtin_amdgcn_exp2f(P0[r]); }while(0)
  #define RESC() do{ if(resc){ asm volatile("s_waitcnt lgkmcnt(0)":::"memory"); \
      _Pragma("unroll") for(int d_=0;d_<2;++d_) _Pragma("unroll") for(int r=0;r<16;++r)o[d_][r]*=wsf[crow(r,hi)]; } }while(0)
  f32x16 pA0,pA1,pB0,pB1;
  int sl_prev=0,sl_cur=0,sl_next=SLOTB;
  #define ROT() do{sl_prev=sl_cur;sl_cur=sl_next;sl_next=(sl_next==(NSLOT-1)*SLOTB)?0:sl_next+SLOTB;}while(0)
  DMA_K(2,2*SLOTB);
  WAIT_BAR(3);
  KBLD(0);
  qkt(pA0,pA1,Kbase,qr,r32,hi,KBF(kbn0),KBF(kbn1),qone); KBLD(1);asm volatile("s_nop 15\n\ts_nop 7":"+v"(pA0),"+v"(pA1));CMASK(pA0,pA1,0);
  START(pA0,pA1);
  _Pragma("unroll") for(int r=0;r<16;++r)pA1[r]=__builtin_amdgcn_exp2f(pA1[r]);
  WAIT_BAR(0);
  DMA_K(3,0);DMA_V(1,SLOTB);
  ROT();
  kload8(kf,kp0+sl_cur);
  WAIT_BAR(2);
  s16x4 vlo[8],vhi[8]; u32x4 pw0,pw1,pw2,pw3;
  #define PKW(P,B) cvtpk_s(P[B],P[B+1])
  #define PAF(k) __builtin_bit_cast(bf16x8,pw##k)
  #define VFR(i) (bf16x8){vlo[i][0],vlo[i][1],vlo[i][2],vlo[i][3],vhi[i][0],vhi[i][1],vhi[i][2],vhi[i][3]}
  #define PIN(x) asm volatile("":"+v"(x))
  #define MX3(a,b,c) __builtin_fmaxf(__builtin_fmaxf((a),(b)),(c))
  #define GAPA(MF,A0,A1,A2,A3,W0,W1,PW) do{ MF; sacc+=A0; sacc+=A1; sacc+=A2; sacc+=A3; PIN(sacc); W0; W1; PIN(PW); SBAR(); }while(0)
  #define EX(v) __builtin_amdgcn_exp2f(v)
  #define GAPB(MF,X,B) do{ MF; X[B]=EX(X[B]); X[B+1]=EX(X[B+1]); X[B+2]=EX(X[B+2]); X[B+3]=EX(X[B+3]); PIN(X); SBAR(); }while(0)
  #define VRD(i) do{ vlo[i]=vtr(vp_+(((i)>>2)*4096+((i)&3)*1024)); vhi[i]=vtr(vp_+(((i)>>2)*4096+((i)&3)*1024+512)); }while(0)
  #define KRD(G,j) do{ if(G){ kload2(kf,kp0+sl_next,j); SBAR(); } }while(0)
  #define STEP(C0,C1,P0,P1,t,GK,GV,GL) do{ SBAR(); \
    const lds_cptr vp_=vp0+sl_prev; \
    C0=__builtin_amdgcn_mfma_f32_32x32x16_bf16(KBF(kbn0),qone,f32x16{},0,0,0); C1=__builtin_amdgcn_mfma_f32_32x32x16_bf16(KBF(kbn1),qone,f32x16{},0,0,0); SBAR(); \
    VRD(0); SBAR(); float sacc=(P0[0]+P0[1]); \
    GAPA(C0=__builtin_amdgcn_mfma_f32_32x32x16_bf16(kf[0],qr[0],C0,0,0,0), P0[2],P0[3],P0[4],P0[5],     pw0[0]=PKW(P0,0), pw0[1]=PKW(P0,2), pw0); \
    VRD(4); SBAR(); GAPA(C1=__builtin_amdgcn_mfma_f32_32x32x16_bf16(kf[1],qr[0],C1,0,0,0), P0[6],P0[7],P0[8],P0[9],     pw0[2]=PKW(P0,4), pw0[3]=PKW(P0,6), pw0); \
    VRD(1); SBAR(); GAPA(C0=__builtin_amdgcn_mfma_f32_32x32x16_bf16(kf[2],qr[1],C0,0,0,0),   P0[10],P0[11],P0[12],P0[13], pw1[0]=PKW(P0,8), pw1[1]=PKW(P0,10), pw1); \
    VRD(5); SBAR(); GAPA(C1=__builtin_amdgcn_mfma_f32_32x32x16_bf16(kf[3],qr[1],C1,0,0,0),   P0[14],P0[15],P1[0],P1[1],   pw1[2]=PKW(P0,12),pw1[3]=PKW(P0,14), pw1); \
    VRD(2); SBAR(); GAPA(C0=__builtin_amdgcn_mfma_f32_32x32x16_bf16(kf[4],qr[2],C0,0,0,0),   P1[2],P1[3],P1[4],P1[5],     pw2[0]=PKW(P1,0), pw2[1]=PKW(P1,2), pw2); \
    VRD(6); SBAR(); GAPA(C1=__builtin_amdgcn_mfma_f32_32x32x16_bf16(kf[5],qr[2],C1,0,0,0),   P1[6],P1[7],P1[8],P1[9],     pw2[2]=PKW(P1,4), pw2[3]=PKW(P1,6), pw2); \
    VRD(3); SBAR(); GAPA(C0=__builtin_amdgcn_mfma_f32_32x32x16_bf16(kf[6],qr[3],C0,0,0,0),   P1[10],P1[11],P1[12],P1[13], pw3[0]=PKW(P1,8), pw3[1]=PKW(P1,10), pw3); \
    VRD(7); SBAR(); GAPA(C1=__builtin_amdgcn_mfma_f32_32x32x16_bf16(kf[7],qr[3],C1,0,0,0),   P1[14],P1[15],0.f,0.f,       pw3[2]=PKW(P1,12),pw3[3]=PKW(P1,14), pw3); \
    l_reg+=sacc; \
    if(GK){DMA_K((t)+3,sl_cur);} if(GV){DMA_V((t)+1,sl_next);} \
    CMASK(C0,C1,t); \
    { float a=MX3(C0[0],C0[1],C1[0]),b=MX3(C0[2],C0[3],C1[1]); a=MX3(a,C1[2],C1[3]); \
      _Pragma("unroll") for(int r=4;r<16;r+=4){a=MX3(a,C0[r],C0[r+1]);b=MX3(b,C0[r+2],C0[r+3]);a=MX3(a,C1[r],C1[r+1]);b=MX3(b,C1[r+2],C1[r+3]);} \
      float rm=__builtin_fmaxf(a,b); { auto rr=__builtin_amdgcn_permlane32_swap(__float_as_uint(rm),__float_as_uint(rm),false,false); rm=__builtin_fmaxf(__uint_as_float(rr[0]),__uint_as_float(rr[1])); } \
      resc=false; \
      if(__builtin_expect(__any(rm>(float)THRL),0)){ const float dl=__builtin_fmaxf(rm,0.f); mhat+=dl; \
        _Pragma("unroll") for(int r=0;r<16;++r){C0[r]-=dl;C1[r]-=dl;} \
        SETNEG(*cqs-mhat); \
        const float f=__builtin_amdgcn_exp2f(-dl); l_reg*=f; if(hi==0)wsf[r32]=f; resc=true; } } \
    SBAR(); \
    GAPB(o[0]=__builtin_amdgcn_mfma_f32_32x32x16_bf16(PAF(0),VFR(0),o[0],0,0,0), C0,0); \
    GAPB(o[1]=__builtin_amdgcn_mfma_f32_32x32x16_bf16(PAF(0),VFR(4),o[1],0,0,0), C0,4); \
    if(GL){KBLD((t)+1);} KRD(GL,0); GAPB(o[0]=__builtin_amdgcn_mfma_f32_32x32x16_bf16(PAF(1),VFR(1),o[0],0,0,0), C0,8); \
    KRD(GL,1); GAPB(o[1]=__builtin_amdgcn_mfma_f32_32x32x16_bf16(PAF(1),VFR(5),o[1],0,0,0), C0,12); \
    KRD(GL,2); GAPB(o[0]=__builtin_amdgcn_mfma_f32_32x32x16_bf16(PAF(2),VFR(2),o[0],0,0,0), C1,0); \
    KRD(GL,3); GAPB(o[1]=__builtin_amdgcn_mfma_f32_32x32x16_bf16(PAF(2),VFR(6),o[1],0,0,0), C1,4); \
    GAPB(o[0]=__builtin_amdgcn_mfma_f32_32x32x16_bf16(PAF(3),VFR(3),o[0],0,0,0), C1,8); \
    GAPB(o[1]=__builtin_amdgcn_mfma_f32_32x32x16_bf16(PAF(3),VFR(7),o[1],0,0,0), C1,12); \
    }while(0)
  int t=1;
  #undef CMASK
  #define CMASK(P0,P1,t) do{}while(0)
  for(;t+5<NT;t+=2){
    STEP(pB0,pB1,pA0,pA1,t,true,true,true);     WAIT_BAR(2); RESC(); ROT();
    STEP(pA0,pA1,pB0,pB1,t+1,true,true,true);   WAIT_BAR(2); RESC(); ROT();
  }
  #undef CMASK
  #define CMASK(P0,P1,t) do{int jb_=(t)-(NT-4); if(jb_>=0)cmask(P0,P1,jb_,qrel,hi);}while(0)
  #define ENDW(tt) do{ if((tt)+3<NT){WAIT_BAR(2);} else if((tt)+2<NT){WAIT_BAR(1);} else {WAIT_BAR(0);} }while(0)
  for(;t+1<NT;t+=2){
    STEP(pB0,pB1,pA0,pA1,t,(t+3<NT),(t+1<NT),(t+1<NT));       ENDW(t);   RESC(); ROT();
    STEP(pA0,pA1,pB0,pB1,t+1,(t+4<NT),(t+2<NT),(t+2<NT));     ENDW(t+1); RESC(); ROT();
  }
  STEP(pB0,pB1,pA0,pA1,NT-1,false,false,false); RESC();
  { float sacc=pB0[0]+pB0[1]; _Pragma("unroll") for(int r=2;r<16;++r)sacc+=pB0[r]; _Pragma("unroll") for(int r=0;r<16;++r)sacc+=pB1[r]; l_reg+=sacc;
    pw0=(u32x4){PKW(pB0,0),PKW(pB0,2),PKW(pB0,4),PKW(pB0,6)};pw1=(u32x4){PKW(pB0,8),PKW(pB0,10),PKW(pB0,12),PKW(pB0,14)};pw2=(u32x4){PKW(pB1,0),PKW(pB1,2),PKW(pB1,4),PKW(pB1,6)};pw3=(u32x4){PKW(pB1,8),PKW(pB1,10),PKW(pB1,12),PKW(pB1,14)};
    const int vb0=(int)(lds0+LDS_V)+((lane>>4)&1)*32+(lane&3)*8+(4*hi+((lane&15)>>2))*64;
    SBAR(); pv(o,vb0+sl_cur,PAF(0),PAF(1),PAF(2),PAF(3)); }
  #undef PKW
  #undef PAF
  #undef VFR
  #undef PIN
  #undef MX3
  #undef GAPA
  #undef GAPB
  #undef EX
  #undef VRD
  #undef KRD
  #undef STEP
  #undef ENDW
  {auto rr=__builtin_amdgcn_permlane32_swap(__float_as_uint(l_reg),__float_as_uint(l_reg),false,false);l_reg=__uint_as_float(rr[0])+__uint_as_float(rr[1]);}
  if(hi==0)wsf[32+r32]=l_reg;asm volatile("s_waitcnt lgkmcnt(0)":::"memory");
  float rli[16];
  #pragma unroll
  for(int r=0;r<16;++r)rli[r]=__builtin_amdgcn_rcpf(wsf[32+crow(r,hi)]);
  bf16*Ow=O+(rowbase+q0+wid*QBLK)*DM+h*D;
  { bf16*stg=(bf16*)(shm+LDS_OST)+wid*2048;
    #pragma unroll
    for(int r=0;r<16;++r){const int orow=crow(r,hi);
      #pragma unroll
      for(int d0=0;d0<2;++d0)stg[orow*64+d0*32+r32]=__float2bfloat16(o[d0][r]*rli[r]);}
    asm volatile("s_waitcnt lgkmcnt(0)":::"memory");
    #pragma unroll
    for(int i=0;i<4;++i){const int row=i*8+(lane>>3),ch=lane&7; const u32x4 v=*(const u32x4*)(stg+row*64+ch*8); if(dostore)ATTN_STORE16(Ow+(long)row*DM+ch*8,v);} }
  asm volatile("s_waitcnt lgkmcnt(0)\n\ts_barrier":::"memory");
  #undef DMA_K
  #undef KBLD
  #undef KBF
  #undef SETNEG
  #undef qone
  #undef DMA_V
  #undef CMASK
  #undef START
  #undef RESC
  #undef ROT
}
constexpr int ATTN_LDS_BYTES=LDS_TOTAL;
#undef SBAR
#undef WAIT_BAR
}

struct Args { const float* in[19]; float* out; unsigned char* ws; int ph; int pad; };
struct Frame {
    LAS unsigned char* lds;
    int tid, lane, wave, G, wave0;
    const float* in[19]; float* out; unsigned char* ws;
};
enum { I_X = 0, I_P, I_GMIX, I_WIN, I_LBL, I_ONG, I_FBIAS, I_QG, I_KG, I_WA, I_WB, I_WOUT, I_GFFN, I_WG, I_WU, I_WD, I_GPLE, I_WPG, I_WPP };

__device__ __forceinline__ void p0_tr_item(const float* W, int Nsrc, int K, bf16_t* WT, int dst_row0, int src_col0, int k0, const float* gain, LAS float* scr, int lane) {
    float tv[32];
#pragma unroll
    for (int i = 0; i < 32; ++i) { const int kk = 2 * i + (lane >> 5); tv[i] = __builtin_nontemporal_load(W + (size_t)(k0 + kk) * Nsrc + src_col0 + (lane & 31)); }
    if (gain) {
#pragma unroll
        for (int i = 0; i < 32; ++i) tv[i] *= gain[k0 + 2 * i + (lane >> 5)]; }
#pragma unroll
    for (int i = 0; i < 32; ++i) scr[(2 * i + (lane >> 5)) * 33 + (lane & 31)] = tv[i];
    LDS_WAIT(); asm volatile("" ::: "memory");
    const int c = lane & 7;
#pragma unroll
    for (int j = 0; j < 4; ++j) { const int n = (lane >> 3) + 8 * j; const LAS float* s = scr + (8 * c) * 33 + n;
        u32x4 o; o.x = pk2(s[0 * 33], s[1 * 33]); o.y = pk2(s[2 * 33], s[3 * 33]); o.z = pk2(s[4 * 33], s[5 * 33]); o.w = pk2(s[6 * 33], s[7 * 33]);
        *(u32x4*)(WT + (size_t)(dst_row0 + n) * K + k0 + 8 * c) = o; }
    LDS_WAIT(); asm volatile("" ::: "memory");
}
__device__ __forceinline__ float log_sigmoid(float v) { return v < 0.f ? v - log1pf(expf(v)) : -log1pf(expf(-v)); }

__device__ __forceinline__ void p0_prologue(Frame& F) {
    LAS float* scr = (LAS float*)(F.lds + F.wave * 16384);
    const int gw = blockIdx.x * NWAVES + F.wave, NGW = F.G * NWAVES;
    unsigned char* ws = F.ws;
    constexpr int IT0 = 16 * 176, IT1 = 8 * 32, IT2 = 8 * 32, IT3 = 16 * 32, IT4 = 16 * 176, IT5 = 44 * 32, IT6 = 16 * 32, IT7 = 4 * 32;
    constexpr int NITEMS = IT0 + IT1 + IT2 + IT3 + IT4 + IT5 + IT6 + IT7;
    for (int it = gw; it < NITEMS; it += NGW) {
        int r = it;
        if (r < IT0) { const int kb = r / 176, nb = r % 176, n0 = nb * 32, pn = n0 >> 8, rho = n0 & 255;
            int zc = n0; if (pn >= 8 && pn < 12) { const int bj = rho >> 7, wc = (rho >> 5) & 3; zc = pn * 256 + 64 * wc + 32 * bj; }
            const int src = zc < ZC_GA ? zc : zc + 8;
            p0_tr_item(F.in[I_WIN], INC, 1024, (bf16_t*)(ws + WS_WIN), n0, src, kb * 64, F.in[I_GMIX], scr, F.lane); continue; } r -= IT0;
        if (r < IT1) { p0_tr_item(F.in[I_WA], 1024, 512, (bf16_t*)(ws + WS_WA), (r % 32) * 32, (r % 32) * 32, (r / 32) * 64, nullptr, scr, F.lane); continue; } r -= IT1;
        if (r < IT2) { p0_tr_item(F.in[I_WB], 1024, 512, (bf16_t*)(ws + WS_WB), (r % 32) * 32, (r % 32) * 32, (r / 32) * 64, nullptr, scr, F.lane); continue; } r -= IT2;
        if (r < IT3) { p0_tr_item(F.in[I_WOUT], 1024, 1024, (bf16_t*)(ws + WS_WOUT), (r % 32) * 32, (r % 32) * 32, (r / 32) * 64, nullptr, scr, F.lane); continue; } r -= IT3;
        if (r < IT4) { const int kb = r / 176, nb = r % 176, n0 = nb * 32, pn = n0 >> 8, rho = n0 & 255, bj = rho >> 7, hid = pn * 128 + (rho & 127);
            p0_tr_item(bj ? F.in[I_WU] : F.in[I_WG], DFF, 1024, (bf16_t*)(ws + WS_WGU), n0, hid, kb * 64, F.in[I_GFFN], scr, F.lane); continue; } r -= IT4;
        if (r < IT5) { p0_tr_item(F.in[I_WD], 1024, DFF, (bf16_t*)(ws + WS_WD), (r % 32) * 32, (r % 32) * 32, (r / 32) * 64, nullptr, scr, F.lane); continue; } r -= IT5;
        if (r < IT6) { p0_tr_item(F.in[I_WPG], 1024, 1024, (bf16_t*)(ws + WS_WPG), (r % 32) * 32, (r % 32) * 32, (r / 32) * 64, F.in[I_GPLE], scr, F.lane); continue; } r -= IT6;
        p0_tr_item(F.in[I_WPP], 1024, PLE, (bf16_t*)(ws + WS_WPP), (r % 32) * 32, (r % 32) * 32, (r / 32) * 64, nullptr, scr, F.lane);
    }
    __syncthreads();
    LAS float* wf = (LAS float*)F.lds;
    for (int idx = F.tid; idx < 2048; idx += NTHR) { const int k = idx >> 1, half = idx & 1;
        f32x4 w = *(const f32x4*)(F.in[I_WIN] + (size_t)k * INC + ZC_GA + 4 * half); const float gk = F.in[I_GMIX][k]; w = w * gk;
        const int l = (k & 255) >> 2, e = k & 3, j = k >> 8; *(LAS f32x4*)(wf + (((j * 4 + e) * 64 + l) * 8 + 4 * half)) = w; }
    __syncthreads();
    const float* x = F.in[I_X]; bf16_t* xb = (bf16_t*)(ws + WS_XB); float* rstd = (float*)(ws + WS_RSTD); float* lf = (float*)(ws + WS_LF);
    f32x4 vn[4], vn2[4];
    { const f32x4* xr0 = (const f32x4*)(x + (size_t)(gw < M ? gw : 0) * DMODEL) + F.lane; const f32x4* xr1 = (const f32x4*)(x + (size_t)(gw + NGW < M ? gw + NGW : 0) * DMODEL) + F.lane;
#pragma unroll
      for (int j = 0; j < 4; ++j) vn[j] = __builtin_nontemporal_load(xr0 + 64 * j);
#pragma unroll
      for (int j = 0; j < 4; ++j) vn2[j] = __builtin_nontemporal_load(xr1 + 64 * j); }
    for (int mrow = gw; mrow < M; mrow += NGW) {
        f32x4 v[4]; float ss = 0.f; float a[8];
#pragma unroll
        for (int j = 0; j < 4; ++j) { v[j] = vn[j]; vn[j] = vn2[j]; }
        { const int nrow = mrow + 2 * NGW < M ? mrow + 2 * NGW : mrow; const f32x4* xr2 = (const f32x4*)(x + (size_t)nrow * DMODEL) + F.lane;
#pragma unroll
          for (int j = 0; j < 4; ++j) vn2[j] = __builtin_nontemporal_load(xr2 + 64 * j); }
#pragma unroll
        for (int h = 0; h < 8; ++h) a[h] = 0.f;
#pragma unroll
        for (int j = 0; j < 4; ++j) { ss += (v[j][0] * v[j][0] + v[j][1] * v[j][1]) + (v[j][2] * v[j][2] + v[j][3] * v[j][3]); }
#pragma unroll
        for (int j = 0; j < 4; ++j)
#pragma unroll
            for (int e = 0; e < 4; ++e) { const LAS f32x4* wp = (const LAS f32x4*)(wf + ((j * 4 + e) * 64 + F.lane) * 8); const f32x4 w0 = wp[0], w1 = wp[1]; const float xv = v[j][e];
#pragma unroll
                for (int h = 0; h < 4; ++h) { a[h] += xv * w0[h]; a[4 + h] += xv * w1[h]; } }
        ss = wave_sum(ss);
        const float rs = 1.0f / sqrtf(ss * (1.0f / DMODEL) + EPS);
#pragma unroll
        for (int h = 0; h < 8; ++h) a[h] = wave_sum(a[h]);
        unsigned long long* o8 = (unsigned long long*)(xb + (size_t)mrow * DMODEL) + F.lane;
#pragma unroll
        for (int j = 0; j < 4; ++j) o8[64 * j] = (unsigned long long)pk2(v[j][0] * rs, v[j][1] * rs) | ((unsigned long long)pk2(v[j][2] * rs, v[j][3] * rs) << 32);
        if (F.lane == 0) rstd[mrow] = rs;
        if (F.lane < 8) {
            float av = a[0];
#pragma unroll
            for (int h = 1; h < 8; ++h) av = (F.lane == h) ? a[h] : av;
            const float z = av * rs + F.in[I_FBIAS][F.lane];
            const int b = mrow >> 12, s = mrow & 4095;
            lf[(size_t)(b * 8 + F.lane) * SEQ + s] = log_sigmoid(z);
        }
    }
    { const float* p = F.in[I_P]; bf16_t* pb = (bf16_t*)(ws + WS_PB); const int gt = blockIdx.x * NTHR + F.tid, NT = F.G * NTHR;
#pragma unroll 4
      for (int i = gt; i < M * PLE / 8; i += NT) { const f32x4 a0 = __builtin_nontemporal_load((const f32x4*)(p + (size_t)i * 8)), a1 = __builtin_nontemporal_load((const f32x4*)(p + (size_t)i * 8 + 4));
          u32x4 w; w.x = pk2(a0[0], a0[1]); w.y = pk2(a0[2], a0[3]); w.z = pk2(a1[0], a1[1]); w.w = pk2(a1[2], a1[3]); *(u32x4*)(pb + (size_t)i * 8) = w; } }
}

__device__ __forceinline__ void fox_scan(Frame& F) {
    if (blockIdx.x >= 64) return;
    const int bh = blockIdx.x; const float* lf = (const float*)(F.ws + WS_LF) + (size_t)bh * SEQ; double* cd = (double*)(F.ws + WS_CD) + (size_t)bh * SEQ;
    LAS double* wtot = (LAS double*)F.lds;
    double loc[8]; double run = 0.0;
    { const f32x4 a0 = *(const f32x4*)(lf + F.tid * 8), a1 = *(const f32x4*)(lf + F.tid * 8 + 4);
#pragma unroll
      for (int j = 0; j < 4; ++j) { run += (double)a0[j]; loc[j] = run; }
#pragma unroll
      for (int j = 0; j < 4; ++j) { run += (double)a1[j]; loc[4 + j] = run; } }
    double inc = run;
#pragma unroll
    for (int o = 1; o < 64; o <<= 1) { const double t = __shfl_up(inc, o); if (F.lane >= o) inc += t; }
    if (F.lane == 63) wtot[F.wave] = inc;
    __syncthreads();
    double base = inc - run;
    for (int w = 0; w < F.wave; ++w) base += wtot[w];
#pragma unroll
    for (int j = 0; j < 8; ++j) cd[F.tid * 8 + j] = base + loc[j];
    LAS double* tend = wtot + 8; LAS double* qc = tend + 64;
    if ((F.tid & 7) == 7) tend[F.tid >> 3] = base + loc[7];
    if ((F.tid & 31) == 0) qc[F.tid >> 5] = base + loc[0];
    __syncthreads();
    if (F.tid < 16) { const int qb = F.tid; int cnt = 0; const double c0 = qc[qb];
        for (int t = 0; t < 4 * qb; ++t) { if (tend[t] - c0 >= 66.0 / 1.4426950408889634) cnt = t + 1; else break; }
        ((int*)(F.ws + WS_T0))[bh * 16 + qb] = cnt & ~1; }
    __syncthreads();
}

namespace hg {
constexpr int RAWQ = 0, RAWF = 16384, RAWV = 32768, RAWG = 49152, QT = 65536, KT = QT + 17408, KPT = KT + 17408, AS = KPT + 18432, DL = AS + 9216, TOT = DL + 512, SSQ = TOT + 2048, END = SSQ + 2048;
constexpr int QP = 272, AP = 144;
typedef short v4i16_t __attribute__((ext_vector_type(4)));
#define HBAR() do { asm volatile("s_waitcnt lgkmcnt(0)" ::: "memory"); __builtin_amdgcn_s_barrier(); asm volatile("" ::: "memory"); } while (0)
__device__ __forceinline__ unsigned cvtpk(float lo, float hi) { typedef float f2 __attribute__((ext_vector_type(2))); typedef __bf16 b2 __attribute__((ext_vector_type(2))); f2 v = {lo, hi}; b2 b = __builtin_convertvector(v, b2); return __builtin_bit_cast(unsigned, b); }
__device__ __forceinline__ float ex2(float x) { return __builtin_amdgcn_exp2f(x); }
#define HSB() __builtin_amdgcn_sched_barrier(0)

constexpr int NSEG = 4, CPS = 64 / NSEG;
template <bool FULL> __device__ __forceinline__ void hgrn_unit(int wave_s, bool dostore, int bh, int seg, bf16_t* Z, const float* og, unsigned char* wsb, LAS unsigned char* lds) {
    const int tid = fresh_tid(wave_s);
    const int lane = tid & 63, w = __builtin_amdgcn_readfirstlane(tid >> 6), l15 = lane & 15, g = lane >> 4;
    const int b = bh >> 2, h = bh & 3;
    bf16_t* zb = Z + (size_t)b * SEQ * ZLD + 128 * h;
    if constexpr (FULL) { for (int i = tid; i < 9216 / 4; i += NTHR) ((LAS unsigned*)(lds + AS))[i] = 0u; }
    float* const Ug = (float*)(wsb + WS_HGU); float* const LBg = (float*)(wsb + WS_HGLB); unsigned* const done = (unsigned*)(wsb + WS_CTL) + 256 + 64 * bh;
    const int c0 = seg * CPS, c1 = c0 + CPS;
    f32x4 Sacc[8];
#pragma unroll
    for (int i = 0; i < 8; ++i) Sacc[i] = (f32x4){0.f, 0.f, 0.f, 0.f};
    u32x4 pre[8];
    const int prow = tid >> 4, pch = tid & 15;
#define HG_PREFETCH(c) do { const int cc_ = (c) < c1 ? (c) : c1 - 1; const bf16_t* p_ = zb + (size_t)(cc_ * 64 + prow) * ZLD + pch * 8; \
        _Pragma("unroll") for (int X = 0; X < 4; ++X) if (FULL || X == 1 || X == 2) { pre[2 * X] = *(const u32x4*)(p_ + X * 512); pre[2 * X + 1] = *(const u32x4*)(p_ + (size_t)32 * ZLD + X * 512); } } while (0)
#define HG_STAGE() do { _Pragma("unroll") for (int X = 0; X < 4; ++X) if (FULL || X == 1 || X == 2) { *(LAS u32x4*)(lds + X * 16384 + prow * 256 + pch * 16) = pre[2 * X]; *(LAS u32x4*)(lds + X * 16384 + (prow + 32) * 256 + pch * 16) = pre[2 * X + 1]; } } while (0)
    const int kk = (w & 1) * 64 + lane, tg = w >> 1;
    if (FULL && seg > 0) {
        if (tid == 0) { while (__hip_atomic_load(done, __ATOMIC_RELAXED, __HIP_MEMORY_SCOPE_AGENT) < (unsigned)(NSEG - 1)) __builtin_amdgcn_s_sleep(2);
            __builtin_amdgcn_fence(__ATOMIC_ACQUIRE, "agent"); asm volatile("s_waitcnt vmcnt(0)" ::: "memory"); }
        __syncthreads();
        for (int j = 0; j < seg; ++j) {
            const float* Uj = Ug + ((size_t)((bh * (NSEG - 1) + j) * 8 + w) * 8) * 256; const float* Lj = LBg + (bh * (NSEG - 1) + j) * 128;
#pragma unroll
            for (int kt = 0; kt < 8; ++kt) { const f32x4 u = *(const f32x4*)(Uj + kt * 256 + lane * 4); const f32x4 l4 = *(const f32x4*)(Lj + 16 * kt + 4 * g);
#pragma unroll
                for (int r = 0; r < 4; ++r) Sacc[kt][r] = Sacc[kt][r] * ex2(l4[r] * LOG2E) + u[r]; }
        }
    }
    HG_PREFETCH(c0); HG_STAGE(); HG_PREFETCH(c0 + 1);
    const float gain = og[16 * w + l15];
    float bsum = 0.f;
    for (int c = c0; c < c1; ++c) {
        HBAR();
        float bl[16], qv[16];
        { bf16_t fr_[16], qr_[16];
#pragma unroll
          for (int i = 0; i < 16; ++i) { fr_[i] = *(const LAS bf16_t*)(lds + RAWF + (16 * tg + i) * 256 + kk * 2); qr_[i] = FULL ? *(const LAS bf16_t*)(lds + RAWQ + (16 * tg + i) * 256 + kk * 2) : (bf16_t)0; }
          HSB();
          float run = 0.f;
#pragma unroll
          for (int i = 0; i < 16; ++i) { run += bf1(fr_[i]); bl[i] = run; qv[i] = bf1(qr_[i]); }
          ((LAS float*)(lds + TOT))[tg * 128 + kk] = run; }
        HBAR();
        { const LAS float* tp = (const LAS float*)(lds + TOT) + kk; const float t0 = tp[0], t1 = tp[128], t2 = tp[256], t3 = tp[384];
          HSB();
          const float prefix = (tg > 0 ? t0 : 0.f) + (tg > 1 ? t1 : 0.f) + (tg > 2 ? t2 : 0.f); const float blast = (t0 + t1) + (t2 + t3);
          const float dlv = ex2(blast * LOG2E); bsum += blast;
          unsigned kp[8], wq[16]; float prevb = 0.f, kprev = 0.f;
#pragma unroll
          for (int i = 0; i < 16; ++i) {
              const float lfv = bl[i] - prevb; prevb = bl[i];
              const float bt = prefix + bl[i];
              const float f = ex2(lfv * LOG2E), kf = 1.0f - f;
              const float enb = ex2(-bt * LOG2E);
              if constexpr (FULL) { const float eb = ex2(bt * LOG2E); wq[i] = cvtpk(qv[i] * eb, kf * enb); } else wq[i] = 0u;
              const float kpv = kf * enb * dlv;
              if (i & 1) kp[i >> 1] = cvtpk(kprev, kpv); else kprev = kpv;
          }
          HSB();
          if (tg == 0) ((LAS float*)(lds + DL))[kk] = dlv;
          if constexpr (FULL) {
#pragma unroll
          for (int i = 0; i < 16; ++i) { const int t = 16 * tg + i;
              *(LAS bf16_t*)(lds + QT + t * QP + kk * 2) = (bf16_t)(wq[i] & 0xffffu);
              *(LAS bf16_t*)(lds + KT + t * QP + kk * 2) = (bf16_t)(wq[i] >> 16); } }
          *(LAS u32x4*)(lds + KPT + kk * AP + (16 * tg) * 2) = (u32x4){kp[0], kp[1], kp[2], kp[3]};
          *(LAS u32x4*)(lds + KPT + kk * AP + (16 * tg) * 2 + 16) = (u32x4){kp[4], kp[5], kp[6], kp[7]}; }
        HBAR();
#define HG_ASTILE(ti, tj) do { f32x4 d_ = (f32x4){0.f, 0.f, 0.f, 0.f}; bf16x8 a_[4], b_[4]; \
            _Pragma("unroll") for (int ks = 0; ks < 4; ++ks) { a_[ks] = *(const LAS bf16x8*)(lds + QT + (16 * (ti) + l15) * QP + (32 * ks + 8 * g) * 2); \
                b_[ks] = *(const LAS bf16x8*)(lds + KT + (16 * (tj) + l15) * QP + (32 * ks + 8 * g) * 2); } \
            HSB(); \
            _Pragma("unroll") for (int ks = 0; ks < 4; ++ks) d_ = __builtin_amdgcn_mfma_f32_16x16x32_bf16(a_[ks], b_[ks], d_, 0, 0, 0); \
            _Pragma("unroll") for (int r = 0; r < 4; r += 2) { const int t_ = 16 * (ti) + 4 * g + r, s_ = 16 * (tj) + l15; \
                const unsigned w_ = cvtpk(s_ <= t_ ? d_[r] : 0.f, s_ <= t_ + 1 ? d_[r + 1] : 0.f); \
                *(LAS bf16_t*)(lds + AS + t_ * AP + s_ * 2) = (bf16_t)(w_ & 0xffffu); *(LAS bf16_t*)(lds + AS + (t_ + 1) * AP + s_ * 2) = (bf16_t)(w_ >> 16); } HSB(); } while (0)
        if constexpr (FULL) {
        if (w == 0) { HG_ASTILE(0, 0); HG_ASTILE(3, 0); }
        else if (w == 1) { HG_ASTILE(1, 1); HG_ASTILE(3, 1); }
        else if (w == 2) { HG_ASTILE(2, 2); }
        else if (w == 3) { HG_ASTILE(3, 3); }
        else if (w == 4) { HG_ASTILE(1, 0); }
        else if (w == 5) { HG_ASTILE(2, 0); }
        else if (w == 6) { HG_ASTILE(2, 1); }
        else { HG_ASTILE(3, 2); }
        }
        bf16x8 vf[2]; f32x4 o[4];
        {
            v4i16_t vlo[2], vhi[2];
            const int q_ = l15 >> 2, p_ = lane & 3;
#pragma unroll
            for (int ts = 0; ts < 2; ++ts) {
                vlo[ts] = __builtin_amdgcn_ds_read_tr16_b64_v4i16((LAS v4i16_t*)(lds + RAWV + (32 * ts + 8 * g + q_) * 256 + (16 * w + 4 * p_) * 2));
                vhi[ts] = __builtin_amdgcn_ds_read_tr16_b64_v4i16((LAS v4i16_t*)(lds + RAWV + (32 * ts + 8 * g + 4 + q_) * 256 + (16 * w + 4 * p_) * 2)); }
#pragma unroll
            for (int mt = 0; mt < 4; ++mt) o[mt] = (f32x4){0.f, 0.f, 0.f, 0.f};
            if constexpr (FULL) {
#pragma unroll
            for (int kh = 0; kh < 2; ++kh) {
                u32x2 a0[2][4], a1[2][4];
#pragma unroll
                for (int k2 = 0; k2 < 2; ++k2)
#pragma unroll
                    for (int mt = 0; mt < 4; ++mt) { const int ks = 2 * kh + k2; a0[k2][mt] = *(const LAS u32x2*)(lds + QT + (16 * mt + l15) * QP + (32 * ks + 4 * g) * 2); a1[k2][mt] = *(const LAS u32x2*)(lds + QT + (16 * mt + l15) * QP + (32 * ks + 16 + 4 * g) * 2); }
                HSB();
#pragma unroll
                for (int k2 = 0; k2 < 2; ++k2) { const int ks = 2 * kh + k2;
                    const u32x4 sbw = (u32x4){cvtpk(Sacc[2 * ks][0], Sacc[2 * ks][1]), cvtpk(Sacc[2 * ks][2], Sacc[2 * ks][3]), cvtpk(Sacc[2 * ks + 1][0], Sacc[2 * ks + 1][1]), cvtpk(Sacc[2 * ks + 1][2], Sacc[2 * ks + 1][3])};
                    const bf16x8 sb = __builtin_bit_cast(bf16x8, sbw);
#pragma unroll
                    for (int mt = 0; mt < 4; ++mt) { const bf16x8 aq = __builtin_bit_cast(bf16x8, (u32x4){a0[k2][mt].x, a0[k2][mt].y, a1[k2][mt].x, a1[k2][mt].y});
                        o[mt] = __builtin_amdgcn_mfma_f32_16x16x32_bf16(aq, sb, o[mt], 0, 0, 0); } }
                HSB();
            }
            } else { HSB(); }
#pragma unroll
            for (int ts = 0; ts < 2; ++ts) vf[ts] = (bf16x8){vlo[ts][0], vlo[ts][1], vlo[ts][2], vlo[ts][3], vhi[ts][0], vhi[ts][1], vhi[ts][2], vhi[ts][3]};
        }
#pragma unroll
        for (int hb = 0; hb < 2; ++hb) {
            bf16x8 akp[4][2]; f32x4 dl4[4];
#pragma unroll
            for (int k4 = 0; k4 < 4; ++k4) { const int kt = 4 * hb + k4; dl4[k4] = *(const LAS f32x4*)(lds + DL + (16 * kt + 4 * g) * 4);
#pragma unroll
                for (int ts = 0; ts < 2; ++ts) akp[k4][ts] = *(const LAS bf16x8*)(lds + KPT + (16 * kt + l15) * AP + (32 * ts + 8 * g) * 2); }
            HSB();
#pragma unroll
            for (int ts = 0; ts < 2; ++ts)
#pragma unroll
                for (int k4 = 0; k4 < 4; ++k4) { const int kt = 4 * hb + k4; const f32x4 cin = ts == 0 ? Sacc[kt] * dl4[k4] : Sacc[kt];
                    Sacc[kt] = __builtin_amdgcn_mfma_f32_16x16x32_bf16(akp[k4][ts], vf[ts], cin, 0, 0, 0); }
            HSB();
        }
        float gv[4][4];
        if constexpr (FULL) {
        { bf16_t gr_[4][4];
#pragma unroll
          for (int mt = 0; mt < 4; ++mt)
#pragma unroll
              for (int r = 0; r < 4; ++r) gr_[mt][r] = *(const LAS bf16_t*)(lds + RAWG + (16 * mt + 4 * g + r) * 256 + (16 * w + l15) * 2);
          HSB();
#pragma unroll
          for (int mt = 0; mt < 4; ++mt)
#pragma unroll
              for (int r = 0; r < 4; ++r) gv[mt][r] = bf1(gr_[mt][r]); }
        HBAR();
        { bf16x8 aa[4][2];
#pragma unroll
          for (int mt = 0; mt < 4; ++mt)
#pragma unroll
              for (int ks = 0; ks < 2; ++ks) { if (ks == 1 && mt < 2) continue; aa[mt][ks] = *(const LAS bf16x8*)(lds + AS + (16 * mt + l15) * AP + (32 * ks + 8 * g) * 2); }
          HSB();
#pragma unroll
          for (int ks = 0; ks < 2; ++ks)
#pragma unroll
              for (int mt = 0; mt < 4; ++mt) { if (ks == 1 && mt < 2) continue; o[mt] = __builtin_amdgcn_mfma_f32_16x16x32_bf16(aa[mt][ks], vf[ks], o[mt], 0, 0, 0); }
          HSB(); }
#pragma unroll
        for (int mt = 0; mt < 4; ++mt)
#pragma unroll
            for (int r = 0; r < 4; ++r) { const float ss = row16_sum(o[mt][r] * o[mt][r]);
                if (l15 == 0) ((LAS float*)(lds + SSQ))[(16 * mt + 4 * g + r) * 8 + w] = ss; }
        }
        HBAR();
        HG_STAGE(); HG_PREFETCH(c + 2);
        if constexpr (FULL) {
        bf16_t* yb = zb + (size_t)(c * 64) * ZLD + ZC_I + 16 * w + l15;
#pragma unroll
        for (int mt = 0; mt < 4; ++mt) { f32x4 s0[4], s1[4];
#pragma unroll
            for (int r = 0; r < 4; ++r) { const LAS f32x4* sp = (const LAS f32x4*)(lds + SSQ + (16 * mt + 4 * g + r) * 32); s0[r] = sp[0]; s1[r] = sp[1]; }
            HSB();
#pragma unroll
            for (int r = 0; r < 4; ++r) { const int t = 16 * mt + 4 * g + r; const f32x4 u0 = s0[r], u1 = s1[r];
                const float tot = ((u0[0] + u0[1]) + (u0[2] + u0[3])) + ((u1[0] + u1[1]) + (u1[2] + u1[3]));
                const float rs = __builtin_amdgcn_rsqf(tot * (1.0f / 128.0f) + EPS);
                if (dostore) yb[(size_t)t * ZLD] = (bf16_t)f2bf(o[mt][r] * rs * gain * gv[mt][r]); }
            HSB(); }
            }
}
    if constexpr (!FULL) {
        float* Uo = Ug + ((size_t)((bh * (NSEG - 1) + seg) * 8 + w) * 8) * 256;
#pragma unroll
        for (int kt = 0; kt < 8; ++kt) *(f32x4*)(Uo + kt * 256 + lane * 4) = Sacc[kt];
        if (tg == 0) LBg[(bh * (NSEG - 1) + seg) * 128 + kk] = bsum;
        asm volatile("s_waitcnt vmcnt(0)" ::: "memory");
        __syncthreads();
        if (tid == 0) { __builtin_amdgcn_fence(__ATOMIC_RELEASE, "agent"); asm volatile("s_waitcnt vmcnt(0)" ::: "memory"); __hip_atomic_fetch_add(done, 1u, __ATOMIC_RELAXED, __HIP_MEMORY_SCOPE_AGENT); }
    }
#undef HG_PREFETCH
#undef HG_STAGE
#undef HG_ASTILE
}
}

constexpr int QSLOT_OFF = LDS_BYTES - 64;
constexpr int N_P1 = 32 * (hg::NSEG - 1), N_S0 = 32, N_FOXA = 128, N_P2 = 32 * (hg::NSEG - 1), N_FOX = 64 * 16;
constexpr int N_ITEMS = N_P1 + N_S0 + N_P2 + N_FOX;
static_assert(hg::END <= QSLOT_OFF && attn_body::ATTN_LDS_BYTES <= QSLOT_OFF, "LDS map");
__device__ __forceinline__ void mix_phase(Frame& F, unsigned char* ldsg) {
    unsigned* ctr = (unsigned*)(F.ws + WS_CTL);
    LAS int* slot = (LAS int*)(F.lds + QSLOT_OFF);
    const attn_body::bf16* Zb = (const attn_body::bf16*)(F.ws + WS_Z);
    for (;;) {
        if (F.tid == 0) *slot = (int)atomicAdd(ctr, 1u);
        __syncthreads();
        const int item = __builtin_amdgcn_readfirstlane(*slot);
        __syncthreads();
        if (item >= N_ITEMS) break;
        int fox = -1;
        if (item < N_P1) hg::hgrn_unit<false>(F.wave0, true, item / (hg::NSEG - 1), item % (hg::NSEG - 1), (bf16_t*)(F.ws + WS_Z), F.in[I_ONG], F.ws, F.lds);
        else if (item < N_P1 + N_S0) hg::hgrn_unit<true>(F.wave0, true, item - N_P1, 0, (bf16_t*)(F.ws + WS_Z), F.in[I_ONG], F.ws, F.lds);
        else if (item < N_P1 + N_S0 + N_FOXA) fox = item - (N_P1 + N_S0);
        else if (item < N_P1 + N_S0 + N_FOXA + N_P2) { const int j = item - (N_P1 + N_S0 + N_FOXA); hg::hgrn_unit<true>(F.wave0, true, j / (hg::NSEG - 1), 1 + j % (hg::NSEG - 1), (bf16_t*)(F.ws + WS_Z), F.in[I_ONG], F.ws, F.lds); }
        else fox = item - (N_P1 + N_S0 + N_P2);
        if (fox >= 0) { const int qb = 15 - (fox >> 6), bh = fox & 63;
          attn_body::attn_unit<8>(F.wave0, true, bh >> 3, bh & 7, qb, __builtin_amdgcn_readfirstlane(((const int*)(F.ws + WS_T0))[bh * 16 + qb]), (const double*)(F.ws + WS_CD) + (size_t)bh * SEQ, Zb + ZC_FQ, Zb + ZC_FK, Zb + ZC_FV, (attn_body::bf16*)(Zb + ZC_FQ), (char*)ldsg); }
    }
}

#define XB_TMO      128
#define XB_XCNT(j)  (256  + 64 * (j))
#define XB_XSUB(j)  (1280 + 64 * (j))
#define XB_XGEN(j)  (2304 + 64 * (j))
#define XB_TOP      3328
#define XB_TOPGEN   3392
#define XB_SPIN_CAP (1u << 22)
__device__ __forceinline__ unsigned xb_ld(unsigned* p)              { return __hip_atomic_load(p, __ATOMIC_RELAXED, __HIP_MEMORY_SCOPE_AGENT); }
__device__ __forceinline__ unsigned xb_add(unsigned* p, unsigned v) { return __hip_atomic_fetch_add(p, v, __ATOMIC_RELAXED, __HIP_MEMORY_SCOPE_AGENT); }
__device__ __forceinline__ unsigned xb_xcc_id() { return (unsigned)__builtin_amdgcn_s_getreg((3 << 11) | 20) & 0xFu; }
#define XB_SPIN(cond, bar) do { unsigned _sp = 0; while (cond) { __builtin_amdgcn_s_sleep(1); \
    if ((++_sp & 255u) == 0u) { if (xb_ld(&(bar)[XB_TMO])) break; if (_sp > XB_SPIN_CAP) { atomicAdd(&(bar)[XB_TMO], 1u); break; } } } } while (0)
__device__ __forceinline__ void xcd_barrier_complete(unsigned* bar, unsigned x, unsigned G, unsigned& nloc, unsigned& nx) {
    unsigned sum, cnt, mine, sp = 0u;
    for (;;) {
        sum = 0u; cnt = 0u; mine = 0u;
#pragma unroll
        for (unsigned j = 0; j < 16; ++j) { const unsigned c = xb_ld(&bar[XB_XCNT(j)]); sum += c; cnt += (c > 0u) ? 1u : 0u; mine = (j == x) ? c : mine; }
        if (sum == G) break;
        __builtin_amdgcn_s_sleep(1);
        if ((++sp & 255u) == 0u) { if (xb_ld(&bar[XB_TMO])) break; if (sp > XB_SPIN_CAP) { atomicAdd(&bar[XB_TMO], 1u); break; } }
    }
    nloc = mine > 0u ? mine : 1u; nx = cnt > 0u ? cnt : 1u;
}
__device__ __forceinline__ void grid_barrier(Frame& F, unsigned* bar, int) {
    const int t = fresh_tid(F.wave0);
    volatile LAS unsigned* st = (volatile LAS unsigned*)(F.lds + QSLOT_OFF + 16);
    asm volatile("s_waitcnt vmcnt(0)" ::: "memory");
    __syncthreads();
    if (t == 0) {
        const unsigned x = xb_xcc_id();
        __builtin_amdgcn_s_waitcnt(0);
        unsigned nloc = st[0], nx = st[1];
        if (nloc == 0u) { xcd_barrier_complete(bar, x, (unsigned)F.G, nloc, nx); st[0] = nloc; st[1] = nx; }
        const unsigned old = xb_add(&bar[XB_XSUB(x)], 1u);
        const unsigned gen = old / nloc;
        if (old + 1u == (gen + 1u) * nloc) {
            __builtin_amdgcn_fence(__ATOMIC_RELEASE, "agent");
            asm volatile("s_waitcnt vmcnt(0)" ::: "memory");
            const unsigned og = xb_add(&bar[XB_TOP], 1u);
            const unsigned tg = og / nx;
            if (og + 1u == (tg + 1u) * nx) xb_add(&bar[XB_TOPGEN], 1u);
            else XB_SPIN(xb_ld(&bar[XB_TOPGEN]) == tg, bar);
            __builtin_amdgcn_fence(__ATOMIC_ACQUIRE, "agent");
            xb_add(&bar[XB_XGEN(x)], 1u);
            asm volatile("s_waitcnt vmcnt(0)" ::: "memory");
        } else {
            XB_SPIN(xb_ld(&bar[XB_XGEN(x)]) == gen, bar);
            __builtin_amdgcn_fence(__ATOMIC_ACQUIRE, "agent");
            asm volatile("s_waitcnt vmcnt(0)" ::: "memory");
        }
    }
    __syncthreads();
}
template <class Epi> __device__ __forceinline__ void run_gemm(Frame& F, const pg8::Gemm& g, const Epi& E) {
    pg8::StaticOrder S; S.init(g.M, g.N, F.G, (int)blockIdx.x);
    pg8::gemm_phase<Epi, true, true>(F.wave0, F.lds, g, S, E);
}

__global__ void __launch_bounds__(NTHR, 2) skel_fwd(Args args) {
    extern __shared__ __attribute__((aligned(16))) unsigned char lds[];
    Frame F;
    F.lds = (LAS unsigned char*)lds; F.tid = 0; F.lane = 0; F.wave = 0; F.G = gridDim.x; F.wave0 = __builtin_amdgcn_readfirstlane((int)threadIdx.x >> 6);
#pragma unroll
    for (int i = 0; i < 19; ++i) F.in[i] = args.in[i];
    F.out = args.out; F.ws = args.ws;
    unsigned char* ws = args.ws;
    bf16_t* Z = (bf16_t*)(ws + WS_Z); bf16_t* XB = (bf16_t*)(ws + WS_XB);
    const int ph = args.ph;
    int seam_no = 0; (void)seam_no;
#if ONE_LAUNCH
    { const int t0_ = fresh_tid(F.wave0); if (t0_ == 0) { volatile LAS unsigned* st = (volatile LAS unsigned*)(F.lds + QSLOT_OFF + 16); st[0] = 0u; st[1] = 0u; (void)xb_add((unsigned*)(ws + WS_CTL) + 8192 + XB_XCNT(xb_xcc_id()), 1u); } __syncthreads(); }
#endif
    if (ph == 0x7ffffff0) cg::this_grid().sync();
#define FRESH() do { const int t_ = fresh_tid(F.wave0); F.tid = t_; F.lane = t_ & 63; F.wave = __builtin_amdgcn_readfirstlane(t_ >> 6); } while (0)
#define IN(k) (ph < 0 || ph == (k))
#if ONE_LAUNCH
#define SEAM() grid_barrier(F, (unsigned*)(ws + WS_CTL) + 8192, seam_no++)
#else
#define SEAM() do {} while (0)
#endif
    if (IN(0)) { FRESH(); p0_prologue(F); SEAM(); }
    if (IN(1)) {
        FRESH(); fox_scan(F);
        pg8::Gemm g{XB, (const bf16_t*)(ws + WS_WIN), M, ZLD, 1024, 1024};
        pg8::EpiIn E{Z, (const float*)(ws + WS_RSTD), F.in[I_LBL], F.in[I_QG], F.in[I_KG]};
        run_gemm(F, g, E);
        SEAM();
    }
    if (IN(2)) {
        FRESH(); mix_phase(F, lds);
        SEAM();
    }
    if (IN(3)) {
        { pg8::Gemm g{Z + ZC_FQ, (const bf16_t*)(ws + WS_WB), M, 1024, 1024, ZLD, 512, Z + ZC_I, (const bf16_t*)(ws + WS_WA), 8};
          pg8::EpiGate E{XB, 1024, Z + ZC_GA, Z + ZC_GB, ZLD}; run_gemm(F, g, E); }
        SEAM();
    }
    if (IN(4)) {
        pg8::Gemm g{XB, (const bf16_t*)(ws + WS_WOUT), M, 1024, 1024, 1024};
        pg8::EpiResid<false> E{F.in[I_X], nullptr, (bf16_t*)(ws + WS_X1B), (float*)(ws + WS_SSQ1)};
        run_gemm(F, g, E); SEAM();
    }
    if (IN(5)) {
        pg8::Gemm g{(const bf16_t*)(ws + WS_X1B), (const bf16_t*)(ws + WS_WGU), M, 2 * DFF, 1024, 1024};
        pg8::EpiSwiglu E{(bf16_t*)(ws + WS_H), (const float*)(ws + WS_SSQ1)};
        run_gemm(F, g, E);
        SEAM();
    }
    if (IN(6)) {
        pg8::Gemm g{(const bf16_t*)(ws + WS_H), (const bf16_t*)(ws + WS_WD), M, 1024, DFF, DFF};
        pg8::EpiResid<true> E{nullptr, (const bf16_t*)(ws + WS_X1B), XB, (float*)(ws + WS_SSQ2)};
        run_gemm(F, g, E); SEAM();
    }
    if (IN(7)) {
        { pg8::Gemm g{(const bf16_t*)(ws + WS_PB), (const bf16_t*)(ws + WS_WPP), M, 1024, PLE, PLE}; pg8::EpiPlain E{(bf16_t*)(ws + WS_PP), 1024}; run_gemm(F, g, E); }
        { pg8::Gemm g{XB, (const bf16_t*)(ws + WS_WPG), M, 1024, 1024, 1024}; pg8::EpiPle E{F.out, XB, (const bf16_t*)(ws + WS_PP), (const float*)(ws + WS_SSQ2)}; run_gemm(F, g, E); }
    }
#undef IN
#undef SEAM
}

extern "C" void kernel_launch(void* const* d_in, const int* in_sizes, int n_in, void* d_out, int out_size, void* d_ws, size_t ws_size, hipStream_t stream) {
    static int grid = 0;
    if (grid == 0) {
        if (n_in != 19 || out_size != M * DMODEL || ws_size < WS_END) { fprintf(stderr, "kernel_launch: unexpected shapes (n_in %d out %d ws %zu)\n", n_in, out_size, ws_size); grid = -1; return; }
        int dev = 0, cus = 0, per_cu = 0;
        hipGetDevice(&dev); hipDeviceGetAttribute(&cus, hipDeviceAttributeMultiprocessorCount, dev);
        hipFuncSetAttribute((const void*)skel_fwd, hipFuncAttributeMaxDynamicSharedMemorySize, LDS_BYTES);
        hipOccupancyMaxActiveBlocksPerMultiprocessor(&per_cu, (const void*)skel_fwd, NTHR, LDS_BYTES);
        if (per_cu < 1) per_cu = 1;
        (void)hipGetLastError();
        grid = cus * per_cu;
    }
    if (grid < 0) return;
    hipMemsetAsync((char*)d_ws + WS_CTL, 0, CTL_ZERO_BYTES, stream);
    Args a{};
    for (int i = 0; i < 19; ++i) a.in[i] = (const float*)d_in[i];
    a.out = (float*)d_out; a.ws = (unsigned char*)d_ws;
#if ONE_LAUNCH
    a.ph = -1;
    void* kargs[] = {&a};
    hipError_t e = hipLaunchCooperativeKernel((const void*)skel_fwd, dim3(grid), dim3(NTHR), kargs, LDS_BYTES, stream);
    if (e != hipSuccess) fprintf(stderr, "cooperative launch failed: %s (grid %d)\n", hipGetErrorString(e), grid);
#else
    const int phases[] = {0, 1, 2, 3, 4, 5, 6, 7};
    for (int ph : phases) { a.ph = ph; hipLaunchKernelGGL(skel_fwd, dim3(grid), dim3(NTHR), LDS_BYTES, stream, a); }
#endif
}
```

```cpp
#include <hip/hip_runtime.h>
#include <hip/hip_cooperative_groups.h>
#include <cstdio>
#include <cstdint>
#include <cmath>
namespace cg = cooperative_groups;

#ifndef ONE_LAUNCH
#define ONE_LAUNCH 1
#endif

#define GAS __attribute__((address_space(1)))
#define LAS __attribute__((address_space(3)))
typedef unsigned short bf16_t;
typedef short bf16x8 __attribute__((ext_vector_type(8)));
typedef float f32x4 __attribute__((ext_vector_type(4)));
typedef float f32x2 __attribute__((ext_vector_type(2)));
typedef unsigned u32x4 __attribute__((ext_vector_type(4)));
typedef unsigned u32x2 __attribute__((ext_vector_type(2)));

constexpr int BATCH = 8, SEQ = 4096, DMODEL = 1024, M = BATCH * SEQ;
constexpr int INC = 5640, ZLD = 5632, DFF = 2816, PLE = 256;
constexpr int ZC_Q = 0, ZC_F = 512, ZC_I = 1024, ZC_G = 1536, ZC_FQ = 2048, ZC_FK = 2560, ZC_FV = 3072, ZC_GA = 3584, ZC_GB = 4608;
constexpr float EPS = 1e-6f;
constexpr float LOG2E = 1.4426950408889634f;
constexpr float C2 = 0.125f * 1.4426950408889634f;
constexpr int NWAVES = 8, NTHR = 512;

constexpr size_t MiB = 1u << 20;
constexpr size_t WS_CTL = 0, CTL_ZERO_BYTES = 1 * MiB;
constexpr size_t WS_WIN = 1 * MiB, WS_WA = 12 * MiB, WS_WB = 13 * MiB, WS_WOUT = 14 * MiB, WS_WGU = 16 * MiB, WS_WD = 27 * MiB, WS_WPG = 33 * MiB, WS_WPP = 35 * MiB;
constexpr size_t WS_T0 = 35 * MiB + 768 * 1024;
constexpr size_t WS_RSTD = 36 * MiB, WS_LF = 36 * MiB + 256 * 1024, WS_CD = 38 * MiB, WS_SSQ1 = 40 * MiB, WS_SSQ2 = 42 * MiB;
constexpr size_t WS_XB = 44 * MiB, WS_PB = 108 * MiB, WS_Z = 124 * MiB;
constexpr size_t WS_HGU = 476 * MiB, WS_HGLB = 484 * MiB;
constexpr size_t WS_X1B = WS_Z, WS_H = WS_Z + 64 * MiB, WS_PP = WS_Z + 240 * MiB, WS_END = WS_Z + 352 * MiB;
static_assert(WS_END <= WS_HGU && WS_HGLB + 65536 <= 512 * MiB, "ws map");
constexpr int LDS_BYTES = 155648;

__device__ __forceinline__ unsigned f2bf(float f) { unsigned u = __builtin_bit_cast(unsigned, f); return (u + 0x7fffu + ((u >> 16) & 1u)) >> 16; }
__device__ __forceinline__ unsigned pk2(float lo, float hi) { typedef float f2_ __attribute__((ext_vector_type(2))); typedef __bf16 b2_ __attribute__((ext_vector_type(2))); f2_ v = {lo, hi}; b2_ b = __builtin_convertvector(v, b2_); return __builtin_bit_cast(unsigned, b); }
__device__ __forceinline__ float bflo(unsigned w) { return __builtin_bit_cast(float, w << 16); }
__device__ __forceinline__ float bfhi(unsigned w) { return __builtin_bit_cast(float, w & 0xffff0000u); }
__device__ __forceinline__ float bf1(bf16_t h) { return __builtin_bit_cast(float, (unsigned)h << 16); }
__device__ __forceinline__ float row16_sum(float v) {
    v += __builtin_bit_cast(float, __builtin_amdgcn_update_dpp(0, __builtin_bit_cast(int, v), 0x128, 0xf, 0xf, false));
    v += __builtin_bit_cast(float, __builtin_amdgcn_update_dpp(0, __builtin_bit_cast(int, v), 0x124, 0xf, 0xf, false));
    v += __builtin_bit_cast(float, __builtin_amdgcn_update_dpp(0, __builtin_bit_cast(int, v), 0x122, 0xf, 0xf, false));
    v += __builtin_bit_cast(float, __builtin_amdgcn_update_dpp(0, __builtin_bit_cast(int, v), 0x121, 0xf, 0xf, false));
    return v;
}
__device__ __forceinline__ float quad_sum(float v) {
    { const unsigned u = __builtin_bit_cast(unsigned, v); auto r = __builtin_amdgcn_permlane16_swap(u, u, false, false); v = __builtin_bit_cast(float, (unsigned)r[0]) + __builtin_bit_cast(float, (unsigned)r[1]); }
    { const unsigned u = __builtin_bit_cast(unsigned, v); auto r = __builtin_amdgcn_permlane32_swap(u, u, false, false); v = __builtin_bit_cast(float, (unsigned)r[0]) + __builtin_bit_cast(float, (unsigned)r[1]); }
    return v;
}
__device__ __forceinline__ float wave_sum(float v) {
    v = row16_sum(v);
    const int iv = __builtin_bit_cast(int, v);
    return (__builtin_bit_cast(float, __builtin_amdgcn_readlane(iv, 0)) + __builtin_bit_cast(float, __builtin_amdgcn_readlane(iv, 16))) +
           (__builtin_bit_cast(float, __builtin_amdgcn_readlane(iv, 32)) + __builtin_bit_cast(float, __builtin_amdgcn_readlane(iv, 48)));
}
__device__ __forceinline__ float sigmoidf_(float v) { return __builtin_amdgcn_rcpf(1.0f + __builtin_amdgcn_exp2f(-1.4426950408889634f * v)); }
__device__ __forceinline__ void unpack8(u32x4 w, float (&f)[8]) { f[0] = bflo(w.x); f[1] = bfhi(w.x); f[2] = bflo(w.y); f[3] = bfhi(w.y); f[4] = bflo(w.z); f[5] = bfhi(w.z); f[6] = bflo(w.w); f[7] = bfhi(w.w); }
__device__ __forceinline__ u32x4 pack8(const float (&f)[8]) { u32x4 w; w.x = pk2(f[0], f[1]); w.y = pk2(f[2], f[3]); w.z = pk2(f[4], f[5]); w.w = pk2(f[6], f[7]); return w; }
#define LDS_WAIT() asm volatile("s_waitcnt lgkmcnt(0)" ::: "memory")
__device__ __forceinline__ int fresh_tid(int wave_s) { unsigned z = 0u; asm volatile("" : "+v"(z)); int t = wave_s * 64 + (int)__builtin_amdgcn_mbcnt_hi(~0u, __builtin_amdgcn_mbcnt_lo(~0u, z)); asm volatile("" : "+v"(t)); return t; }

namespace pg8 {
constexpr int BM = 256, BK = 64, HALF = 128, HTB = HALF * BK * 2, STAGE_BYTES = 8 * HTB, NXCD = 8, WGM = 4;
__host__ __device__ __forceinline__ int lds_byte(int r, int c) { const int st = (r >> 4) * 2 + (c >> 5), rr = r & 15, cc = c & 31, ob = rr * 64 + cc * 2; return st * 1024 + (ob ^ (((ob >> 9) & 1) << 5)); }
__host__ __device__ __forceinline__ void stage_rc(int b, int& R, int& C) { const int st = b / 1024, sb = b % 1024, swz = sb ^ (((sb >> 9) & 1) << 5); R = (st >> 1) * 16 + swz / 64; C = (st & 1) * 32 + (swz % 64) / 2; }
__host__ __device__ __forceinline__ int perm32(int rho) { const int n = rho >> 4, i = rho & 15; return 8 * (i >> 2) + 4 * n + (i & 3); }
struct Unit { int pm, pn; };
struct Gemm { const bf16_t* A; const bf16_t* Bt; int M, N, K, lda; int ldb = 0; const bf16_t* A2 = nullptr; const bf16_t* Bt2 = nullptr; int khalf = 0; };
struct StaticOrder {
    int nM, nN, nwg, G, c;
    __host__ __device__ void init(int M_, int N_, int G_, int c_) { nM = M_ / BM; nN = N_ / BM; nwg = nM * nN; G = G_; c = c_; }
    __host__ __device__ bool next(int i, Unit& u) const {
        const long L = (long)i * G + c; if (L >= nwg) return false;
        int wgid = (int)L; { const int q = nwg / NXCD, r = nwg % NXCD, xcd = wgid % NXCD, off = wgid / NXCD; wgid = (xcd < r ? xcd * (q + 1) : r * (q + 1) + (xcd - r) * q) + off; }
        const int nig = WGM * nN, gid = wgid / nig, fm = gid * WGM, gsz = (nM - fm) < WGM ? (nM - fm) : WGM;
        u.pm = fm + ((wgid % nig) % gsz); u.pn = (wgid % nig) / gsz; return true;
    }
};
typedef f32x4 Acc[2][2][4][2];

template <class Epi, bool ALIGN_EPI = true, bool SP2 = true>
__device__ __forceinline__ void gemm_phase(int wave_s, LAS unsigned char* lds, const Gemm g, const StaticOrder& S, const Epi& E) {
    const int tid = fresh_tid(wave_s);
    const int wid = __builtin_amdgcn_readfirstlane(tid >> 6), lane = tid & 63, wr = wid >> 2, wc = wid & 3, fr = lane & 15, fq = lane >> 4;
    const int K = g.K, nt = K / BK, LDB = g.ldb ? g.ldb : K, kh = g.khalf ? g.khalf : nt;
    unsigned voffA[2], voffB[2];
#pragma unroll
    for (int i = 0; i < 2; ++i) { int R, C; stage_rc(tid * 16 + i * 8192, R, C); const int Rb = (R & ~31) + perm32(R & 31);
        voffA[i] = (unsigned)(R * g.lda + C) * 2u; voffB[i] = (unsigned)(Rb * LDB + C) * 2u; }
    const size_t kstep = (size_t)(BK * 2);
    const size_t hstepA = (size_t)HALF * g.lda * 2, hstepB = (size_t)HALF * LDB * 2;
    const size_t tstepA = 2 * hstepA, tstepB = 2 * hstepB;
    const unsigned ldsw = (unsigned)wid * 1024u;
    const int aoff = lds_byte(wr * 64 + fr, fq * 8), boff = lds_byte(wc * 32 + fr, fq * 8);
#define PG8_SA(b, h) (((b) * 2 + (h)) * HTB)
#define PG8_SB(b, h) ((4 + (b) * 2 + (h)) * HTB)
#define PG8_STAGE(bufoff, gbase, voff) do { _Pragma("unroll") for (int _i = 0; _i < 2; ++_i) \
        __builtin_amdgcn_global_load_lds((const unsigned*)((const char*)(gbase) + (voff)[_i]), (LAS unsigned*)(lds + (bufoff) + ldsw + _i * 8192), 16, 0, 0); } while (0)
#define PG8_LDA(dst, b, h) do { _Pragma("unroll") for (int m = 0; m < 4; ++m) _Pragma("unroll") for (int k = 0; k < 2; ++k) dst[m][k] = *(const LAS bf16x8*)(lds + PG8_SA(b, h) + aoff + m * 2048 + k * 1024); } while (0)
#define PG8_LDB(dst, b, h) do { _Pragma("unroll") for (int n = 0; n < 2; ++n) _Pragma("unroll") for (int k = 0; k < 2; ++k) dst[n][k] = *(const LAS bf16x8*)(lds + PG8_SB(b, h) + boff + n * 2048 + k * 1024); } while (0)
#define PG8_MMA(ai, bj, At, Bt) do { __builtin_amdgcn_s_setprio(1); _Pragma("unroll") for (int m = 0; m < 4; ++m) _Pragma("unroll") for (int n = 0; n < 2; ++n) _Pragma("unroll") for (int k = 0; k < 2; ++k) \
        acc[ai][bj][m][n] = __builtin_amdgcn_mfma_f32_16x16x32_bf16(Bt[n][k], At[m][k], acc[ai][bj][m][n], 0, 0, 0); __builtin_amdgcn_s_setprio(0); } while (0)
#define PG8_WAIT_V(n) asm volatile("s_waitcnt vmcnt(" #n ")" ::: "memory")
#define PG8_WAIT_L(n) asm volatile("s_waitcnt lgkmcnt(" #n ")" ::: "memory")
#define PG8_BAR __builtin_amdgcn_s_barrier()
#define PG8_SCHED __builtin_amdgcn_sched_barrier(0)
    Unit cur, nxt; int ui = 0;
    if (!S.next(0, cur)) return;
    Acc acc;
#pragma unroll
    for (int a = 0; a < 2; ++a)
#pragma unroll
        for (int b = 0; b < 2; ++b)
#pragma unroll
            for (int m = 0; m < 4; ++m)
#pragma unroll
                for (int n = 0; n < 2; ++n) acc[a][b][m][n] = (f32x4){0.f, 0.f, 0.f, 0.f};
    bf16x8 At[4][2], B0[2][2], B1[2][2];
    const char* cA = (const char*)g.A + (size_t)cur.pm * tstepA; const char* cB = (const char*)g.Bt + (size_t)cur.pn * tstepB;
    const char* sA2 = g.khalf ? (const char*)g.A2 : (const char*)g.A + (size_t)kh * kstep; const char* sB2 = g.khalf ? (const char*)g.Bt2 : (const char*)g.Bt + (size_t)kh * kstep;
    const char* cA2 = sA2 + (size_t)cur.pm * tstepA; const char* cB2 = sB2 + (size_t)cur.pn * tstepB;
#define PG8_TA(tt) ((tt) < kh ? cA + (size_t)(tt) * kstep : cA2 + (size_t)((tt) - kh) * kstep)
#define PG8_TB(tt) ((tt) < kh ? cB + (size_t)(tt) * kstep : cB2 + (size_t)((tt) - kh) * kstep)
    if constexpr (SP2) {
        PG8_STAGE(PG8_SB(0, 0), cB, voffB); PG8_STAGE(PG8_SB(0, 1), cB + hstepB, voffB); PG8_STAGE(PG8_SA(0, 0), cA, voffA); PG8_STAGE(PG8_SA(0, 1), cA + hstepA, voffA);
        if (wr == 1) PG8_BAR;
        PG8_WAIT_V(2); PG8_BAR;
        PG8_STAGE(PG8_SB(1, 0), cB + kstep, voffB); PG8_STAGE(PG8_SA(1, 0), cA + kstep, voffA); PG8_STAGE(PG8_SB(1, 1), cB + hstepB + kstep, voffB);
        PG8_WAIT_V(6); PG8_BAR;
    }
    for (;;) {
        const bool has_next = S.next(ui + 1, nxt);
        const char* nA = has_next ? (const char*)g.A + (size_t)nxt.pm * tstepA : cA; const char* nB = has_next ? (const char*)g.Bt + (size_t)nxt.pn * tstepB : cB;
        for (int t = 0; t < nt; t += 2) {
            const bool last = (t == nt - 2);
            const char* a1 = PG8_TA(t + 1);
            const char* a2 = last ? nA : PG8_TA(t + 2); const char* b2 = last ? nB : PG8_TB(t + 2);
            const char* a3 = last ? nA + kstep : PG8_TA(t + 3); const char* b3 = last ? nB + kstep : PG8_TB(t + 3);
            if constexpr (Epi::HAS_MID) { if (t == kh) E.mid(acc, cur, wr, wc, fr, fq); }
            PG8_LDB(B0, 0, 0); PG8_LDB(B1, 0, 1); PG8_SCHED; PG8_LDA(At, 0, 0); PG8_STAGE(PG8_SA(1, 1), a1 + hstepA, voffA);
            PG8_WAIT_V(8); PG8_WAIT_L(0); PG8_BAR; PG8_MMA(0, 0, At, B0); PG8_MMA(0, 1, At, B1); PG8_BAR; PG8_SCHED;
            PG8_LDA(At, 0, 1); PG8_STAGE(PG8_SB(0, 0), b2, voffB); PG8_STAGE(PG8_SB(0, 1), b2 + hstepB, voffB); PG8_STAGE(PG8_SA(0, 0), a2, voffA);
            PG8_WAIT_V(8); PG8_WAIT_L(0); PG8_BAR; PG8_MMA(1, 0, At, B0); PG8_MMA(1, 1, At, B1); PG8_BAR; PG8_SCHED;
            PG8_LDB(B0, 1, 0); PG8_LDB(B1, 1, 1); PG8_SCHED; PG8_LDA(At, 1, 0); PG8_STAGE(PG8_SA(0, 1), a2 + hstepA, voffA);
            PG8_WAIT_V(8); PG8_WAIT_L(0); PG8_BAR; PG8_MMA(0, 0, At, B0); PG8_MMA(0, 1, At, B1); PG8_BAR; PG8_SCHED;
            PG8_LDA(At, 1, 1); PG8_STAGE(PG8_SB(1, 0), b3, voffB); PG8_STAGE(PG8_SB(1, 1), b3 + hstepB, voffB); PG8_STAGE(PG8_SA(1, 0), a3, voffA);
            PG8_WAIT_V(8); PG8_WAIT_L(0); PG8_BAR; PG8_MMA(1, 0, At, B0); PG8_MMA(1, 1, At, B1); PG8_BAR; PG8_SCHED;
        }
        if constexpr (ALIGN_EPI) { if (wr == 0) PG8_BAR; }
        E(acc, cur, wr, wc, fr, fq);
        if (!has_next) break;
#pragma unroll
        for (int a = 0; a < 2; ++a)
#pragma unroll
            for (int b = 0; b < 2; ++b)
#pragma unroll
                for (int m = 0; m < 4; ++m)
#pragma unroll
                    for (int n = 0; n < 2; ++n) acc[a][b][m][n] = (f32x4){0.f, 0.f, 0.f, 0.f};
        cur = nxt; cA = nA; cB = nB; cA2 = sA2 + (size_t)cur.pm * tstepA; cB2 = sB2 + (size_t)cur.pn * tstepB; ++ui;
        if constexpr (ALIGN_EPI) { if (wr == 1) PG8_BAR; }
    }
    PG8_WAIT_V(0);
    if constexpr (!ALIGN_EPI) { if (wr == 0) PG8_BAR; }
    PG8_BAR;
#undef PG8_SA
#undef PG8_SB
#undef PG8_TA
#undef PG8_TB
#undef PG8_STAGE
#undef PG8_LDA
#undef PG8_LDB
#undef PG8_MMA
#undef PG8_WAIT_V
#undef PG8_WAIT_L
#undef PG8_BAR
#undef PG8_SCHED
}

__device__ __forceinline__ void get8(const Acc& acc, int ai, int bj, int m, float (&v)[8]) {
#pragma unroll
    for (int e = 0; e < 4; ++e) { v[e] = acc[ai][bj][m][0][e]; v[4 + e] = acc[ai][bj][m][1][e]; }
}

struct EpiIn {
    static constexpr bool HAS_MID = false;
    bf16_t* Z; const float* rstd; const float* lbl; const float* qg; const float* kg;
    template <int MODE> __device__ __forceinline__ void run(const Acc& acc, const Unit& u, int wr, int wc, int fr, int fq) const {
        constexpr bool HP = (MODE == 3 || MODE == 4);
        int colb[2];
#pragma unroll
        for (int bj = 0; bj < 2; ++bj) colb[bj] = HP ? (u.pn * 256 + 64 * wc + 32 * bj + 8 * fq) : (u.pn * 256 + 128 * bj + 32 * wc + 8 * fq);
        float aux[2][8];
#pragma unroll
        for (int bj = 0; bj < 2; ++bj)
#pragma unroll
            for (int j = 0; j < 8; ++j) {
                if (MODE == 1) { const int k = colb[bj] - ZC_F + j; const float l0 = lbl[k], l1 = lbl[512 + k]; aux[bj][j] = sigmoidf_(l0 - l1); }
                else if (MODE == 3) aux[bj][j] = qg[(colb[bj] + j) & 63] * C2;
                else if (MODE == 4) aux[bj][j] = kg[(colb[bj] + j) & 63];
                else aux[bj][j] = 0.f;
            }
        float one = 1.0f; asm volatile("" : "+v"(one));
#pragma unroll
        for (int ai = 0; ai < 2; ++ai) {
#pragma unroll
            for (int m = 0; m < 4; ++m) {
                const int row = u.pm * 256 + ai * 128 + wr * 64 + m * 16 + fr;
                float v[2][8];
#pragma unroll
                for (int bj = 0; bj < 2; ++bj) { get8(acc, ai, bj, m, v[bj]);
#pragma unroll
                    for (int j = 0; j < 8; ++j) v[bj][j] *= one; }
                if (HP) {
                    float ss = 0.f;
#pragma unroll
                    for (int bj = 0; bj < 2; ++bj)
#pragma unroll
                        for (int j = 0; j < 8; ++j) ss += v[bj][j] * v[bj][j];
                    ss = quad_sum(ss);
                    const float rn = __builtin_amdgcn_rsqf(ss * (1.0f / 64.0f) + EPS);
#pragma unroll
                    for (int bj = 0; bj < 2; ++bj)
#pragma unroll
                        for (int j = 0; j < 8; ++j) v[bj][j] = v[bj][j] * rn * aux[bj][j];
                }
#pragma unroll
                for (int bj = 0; bj < 2; ++bj) {
#pragma unroll
                    for (int j = 0; j < 8; ++j) {
                        float x = v[bj][j];
                        if (MODE == 0) x = x * sigmoidf_(x);
                        else if (MODE == 1) { const float lb = aux[bj][j]; const float fg = lb + (1.0f - lb) * sigmoidf_(x); x = 0.6931471805599453f * __builtin_amdgcn_logf(fg); }
                        else if (MODE == 5) x = sigmoidf_(x);
                        v[bj][j] = x;
                    }
                    __builtin_nontemporal_store(pack8(v[bj]), (u32x4*)(Z + (size_t)row * ZLD + colb[bj]));
                }
                __builtin_amdgcn_sched_barrier(0);
            }
        }
    }
    __device__ __forceinline__ void operator()(const Acc& acc, const Unit& u, int wr, int wc, int fr, int fq) const {
        const int pn = u.pn;
        if (pn < 2) run<0>(acc, u, wr, wc, fr, fq);
        else if (pn < 4) run<1>(acc, u, wr, wc, fr, fq);
        else if (pn < 6) run<2>(acc, u, wr, wc, fr, fq);
        else if (pn < 8) run<0>(acc, u, wr, wc, fr, fq);
        else if (pn < 10) run<3>(acc, u, wr, wc, fr, fq);
        else if (pn < 12) run<4>(acc, u, wr, wc, fr, fq);
        else if (pn < 14) run<2>(acc, u, wr, wc, fr, fq);
        else run<5>(acc, u, wr, wc, fr, fq);
    }
};

struct EpiGate {
    static constexpr bool HAS_MID = true;
    bf16_t* out; int ldo; const bf16_t* ga; const bf16_t* gb; int ldg;
    __device__ __forceinline__ void mid(Acc& acc, const Unit& u, int wr, int wc, int fr_, int fq) const {
        int fr = fr_; asm volatile("" : "+v"(fr));
#pragma unroll
        for (int ai = 0; ai < 2; ++ai)
#pragma unroll
            for (int m = 0; m < 4; ++m) {
                u32x4 aw[2], bw[2];
#pragma unroll
                for (int bj = 0; bj < 2; ++bj) { const size_t off = (size_t)(u.pm * 256 + ai * 128 + wr * 64 + m * 16 + fr) * ldg + u.pn * 256 + 128 * bj + 32 * wc + 8 * fq;
                    aw[bj] = *(const u32x4*)(ga + off); bw[bj] = *(const u32x4*)(gb + off); }
                if (m & 1) __builtin_amdgcn_sched_barrier(0);
#pragma unroll
                for (int bj = 0; bj < 2; ++bj) { float a8[8], b8[8]; unpack8(aw[bj], a8); unpack8(bw[bj], b8);
#pragma unroll
                    for (int e = 0; e < 4; ++e) { acc[ai][bj][m][0][e] *= b8[e] * __builtin_amdgcn_rcpf(a8[e]); acc[ai][bj][m][1][e] *= b8[4 + e] * __builtin_amdgcn_rcpf(a8[4 + e]); } }
            }
    }
    __device__ __forceinline__ void operator()(const Acc& acc, const Unit& u, int wr, int wc, int fr, int fq) const {
#pragma unroll
        for (int ai = 0; ai < 2; ++ai) {
            u32x4 gw[4][2];
#pragma unroll
            for (int m = 0; m < 4; ++m)
#pragma unroll
                for (int bj = 0; bj < 2; ++bj) gw[m][bj] = *(const u32x4*)(ga + (size_t)(u.pm * 256 + ai * 128 + wr * 64 + m * 16 + fr) * ldg + u.pn * 256 + 128 * bj + 32 * wc + 8 * fq);
            __builtin_amdgcn_sched_barrier(0);
#pragma unroll
            for (int m = 0; m < 4; ++m)
#pragma unroll
                for (int bj = 0; bj < 2; ++bj) { const int row = u.pm * 256 + ai * 128 + wr * 64 + m * 16 + fr, col = u.pn * 256 + 128 * bj + 32 * wc + 8 * fq;
                    float v[8], gt[8]; get8(acc, ai, bj, m, v); unpack8(gw[m][bj], gt);
#pragma unroll
                    for (int j = 0; j < 8; ++j) v[j] = gt[j] * v[j];
                    *(u32x4*)(out + (size_t)row * ldo + col) = pack8(v); }
            __builtin_amdgcn_sched_barrier(0);
        }
    }
};

template <bool BF16IN> struct EpiResid {
    static constexpr bool HAS_MID = false;
    const float* xin; const bf16_t* xinb; bf16_t* xb; float* ssq;
    __device__ __forceinline__ void operator()(const Acc& acc, const Unit& u, int wr, int wc, int fr, int fq) const {
#pragma unroll
        for (int ai = 0; ai < 2; ++ai)
#pragma unroll
            for (int mh = 0; mh < 2; ++mh) {
                f32x4 x0[2][2], x1[2][2]; u32x4 xw[2][2];
#pragma unroll
                for (int m2 = 0; m2 < 2; ++m2)
#pragma unroll
                    for (int bj = 0; bj < 2; ++bj) { const size_t off = (size_t)(u.pm * 256 + ai * 128 + wr * 64 + (2 * mh + m2) * 16 + fr) * DMODEL + u.pn * 256 + 128 * bj + 32 * wc + 8 * fq;
                        if constexpr (BF16IN) xw[m2][bj] = *(const u32x4*)(xinb + off); else { x0[m2][bj] = *(const f32x4*)(xin + off); x1[m2][bj] = *(const f32x4*)(xin + off + 4); } }
                __builtin_amdgcn_sched_barrier(0);
#pragma unroll
                for (int m2 = 0; m2 < 2; ++m2) {
                    const int m = 2 * mh + m2;
                    const int row = u.pm * 256 + ai * 128 + wr * 64 + m * 16 + fr;
                    float ss = 0.f;
#pragma unroll
                    for (int bj = 0; bj < 2; ++bj) {
                        const size_t off = (size_t)row * DMODEL + u.pn * 256 + 128 * bj + 32 * wc + 8 * fq;
                        float v[8], xr[8]; get8(acc, ai, bj, m, v);
                        if constexpr (BF16IN) unpack8(xw[m2][bj], xr);
                        else {
#pragma unroll
                            for (int j = 0; j < 4; ++j) { xr[j] = x0[m2][bj][j]; xr[4 + j] = x1[m2][bj][j]; } }
#pragma unroll
                        for (int j = 0; j < 8; ++j) { v[j] += xr[j]; ss += v[j] * v[j]; }
                        *(u32x4*)(xb + off) = pack8(v);
                    }
                    ss = quad_sum(ss);
                    if (fq == 0) ssq[(size_t)row * 16 + u.pn * 4 + wc] = ss;
                }
                __builtin_amdgcn_sched_barrier(0);
            }
    }
};
__device__ __forceinline__ void rstd8_from_ssq(const float* ssq, const Unit& u, int wr, int fr, int fq, float (&rs)[2][4]) {
    f32x4 sq[2][4];
#pragma unroll
    for (int ai = 0; ai < 2; ++ai)
#pragma unroll
        for (int m = 0; m < 4; ++m) sq[ai][m] = *(const f32x4*)(ssq + (size_t)(u.pm * 256 + ai * 128 + wr * 64 + m * 16 + fr) * 16 + 4 * fq);
    __builtin_amdgcn_sched_barrier(0);
    float p[2][4];
#pragma unroll
    for (int ai = 0; ai < 2; ++ai)
#pragma unroll
        for (int m = 0; m < 4; ++m) p[ai][m] = (sq[ai][m][0] + sq[ai][m][1]) + (sq[ai][m][2] + sq[ai][m][3]);
#pragma unroll
    for (int ai = 0; ai < 2; ++ai)
#pragma unroll
        for (int m = 0; m < 4; ++m) p[ai][m] = quad_sum(p[ai][m]);
#pragma unroll
    for (int ai = 0; ai < 2; ++ai)
#pragma unroll
        for (int m = 0; m < 4; ++m) rs[ai][m] = __builtin_amdgcn_rsqf(p[ai][m] * (1.0f / DMODEL) + EPS);
}
__device__ __forceinline__ float rstd_from_ssq(const float* ssq, int row) {
    const f32x4* p = (const f32x4*)(ssq + (size_t)row * 16);
    const f32x4 a = p[0], b = p[1], c = p[2], d = p[3];
    const float s = ((a[0] + a[1]) + (a[2] + a[3])) + ((b[0] + b[1]) + (b[2] + b[3])) + ((c[0] + c[1]) + (c[2] + c[3])) + ((d[0] + d[1]) + (d[2] + d[3]));
    return 1.0f / sqrtf(s * (1.0f / DMODEL) + EPS);
}
struct EpiSwiglu {
    static constexpr bool HAS_MID = false;
    bf16_t* H; const float* ssq;
    __device__ __forceinline__ void operator()(const Acc& acc, const Unit& u, int wr, int wc, int fr, int fq) const {
        float rsv[2][4]; rstd8_from_ssq(ssq, u, wr, fr, fq, rsv);
#pragma unroll
        for (int ai = 0; ai < 2; ++ai)
#pragma unroll
            for (int m = 0; m < 4; ++m) {
                const int row = u.pm * 256 + ai * 128 + wr * 64 + m * 16 + fr;
                const float rs = rsv[ai][m];
                float gv[8], uv[8]; get8(acc, ai, 0, m, gv); get8(acc, ai, 1, m, uv);
#pragma unroll
                for (int j = 0; j < 8; ++j) { const float gg = gv[j] * rs; gv[j] = gg * sigmoidf_(gg) * (uv[j] * rs); }
                *(u32x4*)(H + (size_t)row * DFF + u.pn * 128 + 32 * wc + 8 * fq) = pack8(gv);
            }
    }
};
struct EpiPlain {
    static constexpr bool HAS_MID = false;
    bf16_t* out; int ldo;
    __device__ __forceinline__ void operator()(const Acc& acc, const Unit& u, int wr, int wc, int fr, int fq) const {
#pragma unroll
        for (int ai = 0; ai < 2; ++ai)
#pragma unroll
            for (int m = 0; m < 4; ++m) {
                const int row = u.pm * 256 + ai * 128 + wr * 64 + m * 16 + fr;
#pragma unroll
                for (int bj = 0; bj < 2; ++bj) { float v[8]; get8(acc, ai, bj, m, v); *(u32x4*)(out + (size_t)row * ldo + u.pn * 256 + 128 * bj + 32 * wc + 8 * fq) = pack8(v); }
            }
    }
};
struct EpiPle {
    static constexpr bool HAS_MID = false;
    float* out; const bf16_t* x2b; const bf16_t* pp; const float* ssq;
    __device__ __forceinline__ void operator()(const Acc& acc, const Unit& u, int wr, int wc, int fr, int fq) const {
        float rsv[2][4]; rstd8_from_ssq(ssq, u, wr, fr, fq, rsv);
#pragma unroll
        for (int ai = 0; ai < 2; ++ai) {
            u32x4 xw[4][2], pw[4][2];
#pragma unroll
            for (int m = 0; m < 4; ++m)
#pragma unroll
                for (int bj = 0; bj < 2; ++bj) { const size_t off = (size_t)(u.pm * 256 + ai * 128 + wr * 64 + m * 16 + fr) * DMODEL + u.pn * 256 + 128 * bj + 32 * wc + 8 * fq;
                    xw[m][bj] = *(const u32x4*)(x2b + off); pw[m][bj] = *(const u32x4*)(pp + off); }
            __builtin_amdgcn_sched_barrier(0);
#pragma unroll
            for (int m = 0; m < 4; ++m) {
                const float rs = rsv[ai][m];
#pragma unroll
                for (int bj = 0; bj < 2; ++bj) {
                    const size_t off = (size_t)(u.pm * 256 + ai * 128 + wr * 64 + m * 16 + fr) * DMODEL + u.pn * 256 + 128 * bj + 32 * wc + 8 * fq;
                    float v[8], pv[8], xr[8]; get8(acc, ai, bj, m, v); unpack8(pw[m][bj], pv); unpack8(xw[m][bj], xr);
#pragma unroll
                    for (int j = 0; j < 8; ++j) v[j] = xr[j] + sigmoidf_(v[j] * rs) * pv[j];
                    *(f32x4*)(out + off) = (f32x4){v[0], v[1], v[2], v[3]}; *(f32x4*)(out + off + 4) = (f32x4){v[4], v[5], v[6], v[7]};
                }
            }
            __builtin_amdgcn_sched_barrier(0);
        }
    }
};
}

#include <hip/hip_bf16.h>
#include <cmath>
namespace attn_body {
using bf16=__hip_bfloat16;
using bf16x8=__attribute__((ext_vector_type(8)))short;
using s16x4=__attribute__((ext_vector_type(4)))short;
using f32x16=__attribute__((ext_vector_type(16)))float;
using u32x4=__attribute__((ext_vector_type(4)))unsigned;
constexpr int BATCH=8,NHEAD=8,SEQ=4096,D=64,DM=5632;
constexpr int NW=8,QBLK=32,QB=QBLK*NW,KVBLK=64,NQB=SEQ/QB;
constexpr int ATTN_PITCH=DM, ATTN_UNIT_ROWS=QB;
__device__ __forceinline__ int crow(int r,int hi){return (r&3)+8*(r>>2)+4*hi;}
#define SBAR() __builtin_amdgcn_sched_barrier(0)
__device__ __forceinline__ void cmask(f32x16&p0,f32x16&p1,int jb,int qrel,int hi){
  const float NEG=-INFINITY; int kb=64*jb+4*hi;
  #pragma unroll
  for(int r=0;r<16;++r){int kv=kb+(r&3)+8*(r>>2); if(kv>qrel)p0[r]=NEG; if(kv+32>qrel)p1[r]=NEG;}
}

constexpr int NSLOT=3, SLOTB=8192;
constexpr int LDS_K=0, LDS_V=NSLOT*SLOTB, LDS_WS=2*NSLOT*SLOTB, LDS_OST=LDS_WS+NW*64*4, LDS_BYTES=LDS_OST+NW*4096, LDS_CB=LDS_BYTES, LDS_CQ=LDS_CB+32768, LDS_TOTAL=LDS_CQ+NW*128;
constexpr float C2=0.125f*1.4426950408889634f;
__device__ __forceinline__ void glds16(const void*gsrc,unsigned lds_dst){unsigned keep;
  asm volatile("s_mov_b32 %0, m0\n\ts_mov_b32 m0, %2\n\ts_nop 0\n\tglobal_load_lds_dwordx4 %1, off\n\ts_mov_b32 m0, %0":"=&s"(keep):"v"(gsrc),"s"(lds_dst):"memory");}
__device__ __forceinline__ float max3f(float a,float b,float c){float r;asm("v_max3_f32 %0, %1, %2, %3":"=v"(r):"v"(a),"v"(b),"v"(c));return r;}
__device__ __forceinline__ float max2f(float a,float b){float r;asm("v_max_f32_e32 %0, %1, %2":"=v"(r):"v"(a),"v"(b));return r;}
__device__ __forceinline__ float fadd_s(float a,float b){float r;asm("v_add_f32_e32 %0, %1, %2":"=v"(r):"v"(a),"v"(b));return r;}
__device__ __forceinline__ float fsub_s(float a,float b){float r;asm("v_sub_f32_e32 %0, %1, %2":"=v"(r):"v"(a),"v"(b));return r;}
typedef float f32x2_t __attribute__((ext_vector_type(2))); typedef unsigned u32x2v __attribute__((ext_vector_type(2))); typedef __bf16 bf16x2_t __attribute__((ext_vector_type(2)));
__device__ __forceinline__ unsigned cvtpk_s(float lo,float hi){f32x2_t v={lo,hi};bf16x2_t b=__builtin_convertvector(v,bf16x2_t);return __builtin_bit_cast(unsigned,b);}
#define WAIT_BAR(N) asm volatile("s_waitcnt vmcnt(" #N ") lgkmcnt(0)\n\ts_barrier":::"memory")

__device__ __forceinline__ void qkt(f32x16&p0,f32x16&p1,const char*Kslot,const bf16x8*qr,int r32,int hi,bf16x8 kb0,bf16x8 kb1,bf16x8 qone){
  const char*kb=Kslot+hi*1024+r32*16;
  #pragma unroll
  for(int d0=0;d0<4;++d0){
    const bf16x8 b0=*reinterpret_cast<const bf16x8*>(kb+d0*2048);
    const bf16x8 b1=*reinterpret_cast<const bf16x8*>(kb+d0*2048+512);
    if(d0==0){p0=__builtin_amdgcn_mfma_f32_32x32x16_bf16(kb0,qone,f32x16{},0,0,0);p1=__builtin_amdgcn_mfma_f32_32x32x16_bf16(kb1,qone,f32x16{},0,0,0);}
    p0=__builtin_amdgcn_mfma_f32_32x32x16_bf16(b0,qr[d0],p0,0,0,0);p1=__builtin_amdgcn_mfma_f32_32x32x16_bf16(b1,qr[d0],p1,0,0,0);}
}
typedef __attribute__((address_space(3))) const char* lds_cptr;
typedef short v4i16_t __attribute__((ext_vector_type(4)));
__device__ __forceinline__ void kload8(bf16x8*kf,lds_cptr kp){
  kf[0]=*(const __attribute__((address_space(3))) bf16x8*)(kp);      kf[1]=*(const __attribute__((address_space(3))) bf16x8*)(kp+512);
  kf[2]=*(const __attribute__((address_space(3))) bf16x8*)(kp+2048); kf[3]=*(const __attribute__((address_space(3))) bf16x8*)(kp+2560);
  kf[4]=*(const __attribute__((address_space(3))) bf16x8*)(kp+4096); kf[5]=*(const __attribute__((address_space(3))) bf16x8*)(kp+4608);
  kf[6]=*(const __attribute__((address_space(3))) bf16x8*)(kp+6144); kf[7]=*(const __attribute__((address_space(3))) bf16x8*)(kp+6656);
}
__device__ __forceinline__ void kload2(bf16x8*kf,lds_cptr kp,int j){ kf[2*j]=*(const __attribute__((address_space(3))) bf16x8*)(kp+j*2048); kf[2*j+1]=*(const __attribute__((address_space(3))) bf16x8*)(kp+j*2048+512); }
__device__ __forceinline__ s16x4 vtr(lds_cptr p){ return __builtin_bit_cast(s16x4,__builtin_amdgcn_ds_read_tr16_b64_v4i16((__attribute__((address_space(3))) v4i16_t*)p)); }
__device__ __forceinline__ float rowmax(const f32x16&p0,const f32x16&p1){
  float a=max3f(p0[0],p0[1],p1[0]),b=max3f(p0[2],p0[3],p1[1]);a=max3f(a,p1[2],p1[3]);
  #pragma unroll
  for(int r=4;r<16;r+=4){a=max3f(a,p0[r],p0[r+1]);b=max3f(b,p0[r+2],p0[r+3]);a=max3f(a,p1[r],p1[r+1]);b=max3f(b,p1[r+2],p1[r+3]);}
  const float m=max2f(a,b);
  auto rr=__builtin_amdgcn_permlane32_swap(__float_as_uint(m),__float_as_uint(m),false,false);
  return max2f(__uint_as_float(rr[0]),__uint_as_float(rr[1]));
}
__device__ __forceinline__ void pv(f32x16*o,int vb,bf16x8 pa0,bf16x8 pa1,bf16x8 pa2,bf16x8 pa3){
  #pragma unroll
  for(int d0=0;d0<2;++d0){s16x4 lo[4],hi[4];
    #pragma unroll
    for(int ks=0;ks<4;++ks){
      asm volatile("ds_read_b64_tr_b16 %0,%1 offset:%c2":"=&v"(lo[ks]):"v"(vb),"i"(d0*4096+ks*1024):"memory");
      asm volatile("ds_read_b64_tr_b16 %0,%1 offset:%c2":"=&v"(hi[ks]):"v"(vb),"i"(d0*4096+ks*1024+512):"memory");}
    asm volatile("s_waitcnt lgkmcnt(0)":::"memory");SBAR();
    #define PK(k) (bf16x8){lo[k][0],lo[k][1],lo[k][2],lo[k][3],hi[k][0],hi[k][1],hi[k][2],hi[k][3]}
    o[d0]=__builtin_amdgcn_mfma_f32_32x32x16_bf16(pa0,PK(0),o[d0],0,0,0);
    o[d0]=__builtin_amdgcn_mfma_f32_32x32x16_bf16(pa1,PK(1),o[d0],0,0,0);
    o[d0]=__builtin_amdgcn_mfma_f32_32x32x16_bf16(pa2,PK(2),o[d0],0,0,0);
    o[d0]=__builtin_amdgcn_mfma_f32_32x32x16_bf16(pa3,PK(3),o[d0],0,0,0);
    #undef PK
  }
}

#ifndef ATTN_STORE16
#define ATTN_STORE16(p,v) (*(u32x4*)(p)=(v))
#endif
template<int THRL> __device__ __forceinline__ void attn_unit(int wave_s,bool dostore,int b,int h,int qb,int t0,const double*cdh,const bf16*Q,const bf16*__restrict__ K,const bf16*__restrict__ V,bf16*O,char*shm){
  const int tid=fresh_tid(wave_s); const int lane=tid&63,r32=lane&31,hi=lane>>5; const int wid=__builtin_amdgcn_readfirstlane(tid>>6);
  const long rowbase=(long)b*SEQ; const int q0=qb*QB;
  const bf16*Qw=Q+(rowbase+q0+wid*QBLK)*DM+h*D;
  const bf16*Kh=K+(rowbase+t0*KVBLK)*DM+h*D,*Vh=V+(rowbase+t0*KVBLK)*DM+h*D;
  const unsigned lds0=(unsigned)(uintptr_t)shm;
  float*wsf=(float*)(shm+LDS_WS)+wid*64;
  const bf16*ksrc=Kh+(long)lane*DM+wid*8;
  const bf16*vsrc=Vh+(long)(16*(wid&3)+(lane>>2))*DM+(wid>>2)*32+(lane&3)*8;
  const unsigned kdst=lds0+LDS_K+wid*1024, vdst=lds0+LDS_V+wid*1024;
  #define DMA_K(t,slot) glds16(ksrc+(long)(t)*KVBLK*DM,(unsigned)__builtin_amdgcn_readfirstlane(kdst+(slot)))
  #define DMA_V(t,slot) glds16(vsrc+(long)(t)*KVBLK*DM,(unsigned)__builtin_amdgcn_readfirstlane(vdst+(slot)))
  const char*Kbase=shm+LDS_K; bf16x8 kf[8];
  const lds_cptr shm3=(lds_cptr)shm; const lds_cptr kp0=shm3+LDS_K+hi*1024+r32*16; const lds_cptr vp0=shm3+LDS_V+((lane>>4)&1)*32+(lane&3)*8+(4*hi+((lane&15)>>2))*64;
  const int NT=(q0+QB)/KVBLK-t0;
  const lds_cptr cbp=shm3+LDS_CB+r32*8; float cq; float*cqs=(float*)(shm+LDS_CQ)+wid*32+r32;
  DMA_K(0,0);DMA_V(0,0);DMA_K(1,SLOTB);
  { const double c0=cdh[q0]; const int nk=q0+QB-t0*KVBLK; const double*cs=cdh+t0*KVBLK;
    double cv[8]; const double cqd=cdh[q0+wid*QBLK+r32];
    #pragma unroll
    for(int j=0;j<8;++j){ const int i=tid+j*NW*64; cv[j]=cs[i<nk?i:nk-1]; }
    #pragma unroll
    for(int j=0;j<8;++j){ const int i=tid+j*NW*64; if(i<nk){ const float kbv=(float)((c0-cv[j])*1.4426950408889634);
      const unsigned uh=__float_as_uint(kbv)&0xffff0000u; const float r1=kbv-__uint_as_float(uh);
      const unsigned um=__float_as_uint(r1)&0xffff0000u; const float r2=r1-__uint_as_float(um);
      const unsigned ul=__float_as_uint(r2)&0xffff0000u;
      *(__attribute__((address_space(3))) u32x2v*)((__attribute__((address_space(3))) char*)(shm3+LDS_CB)+i*8)=(u32x2v){(uh>>16)|um,(ul>>16)|0x3F800000u}; } }
    cq=(float)((cqd-c0)*1.4426950408889634); if(hi==0)*cqs=cq; }
  u32x4 qb4=(u32x4){hi?0u:0x3F803F80u,0u,0u,0u};
  #define SETNEG(val) do{ const float nv_=(val); const unsigned nh_=__float_as_uint(nv_)&0xffff0000u; const float n1_=nv_-__uint_as_float(nh_); \
    const unsigned nm_=__float_as_uint(n1_)&0xffff0000u; const float n2_=n1_-__uint_as_float(nm_); const unsigned nl_=__float_as_uint(n2_)&0xffff0000u; \
    qb4[1]=hi?0u:(0x3F80u|nh_); qb4[2]=hi?0u:((nm_>>16)|nl_); }while(0)
  #define qone __builtin_bit_cast(bf16x8,qb4)
  u32x2v kbn0,kbn1;
  #define KBLD(t) do{ kbn0=*(const __attribute__((address_space(3))) u32x2v*)(cbp+(t)*512); kbn1=*(const __attribute__((address_space(3))) u32x2v*)(cbp+(t)*512+256); }while(0)
  #define KBF(x) __builtin_bit_cast(bf16x8,(u32x4){x[0],x[1],0x3F803F80u,0u})
  bf16x8 qr[4];
  #pragma unroll
  for(int d0=0;d0<4;++d0)qr[d0]=*reinterpret_cast<const bf16x8*>(&Qw[(long)r32*DM+d0*16+hi*8]);
  float mhat=0.f,l_reg=0.f;f32x16 o[2];o[0]=f32x16{};o[1]=f32x16{};SETNEG(cq);
  const int qrel=wid*QBLK+r32;
  #define CMASK(P0,P1,t) do{int jb_=(t)-(NT-4); if(jb_>=0)cmask(P0,P1,jb_,qrel,hi);}while(0)
  bool resc=false;
  #define START(P0,P1) do{ const float rm=rowmax(P0,P1); resc=false; \
    { const float dl=rm; mhat=fadd_s(mhat,dl); \
      _Pragma("unroll") for(int r=0;r<16;++r){P0[r]=fsub_s(P0[r],dl);P1[r]=fsub_s(P1[r],dl);} \
      SETNEG(*cqs-mhat); } \
    _Pragma("unroll") for(int r=0;r<16;++r)P0[r]=__builtin_amdgcn_exp2f(P0[r]); }while(0)
  #define RESC() do{ if(resc){ asm volatile("s_waitcnt lgkmcnt(0)":::"memory"); \
      _Pragma("unroll") for(int d_=0;d_<2;++d_) _Pragma("unroll") for(int r=0;r<16;++r)o[d_][r]*=wsf[crow(r,hi)]; } }while(0)
  f32x16 pA0,pA1,pB0,pB1;
  int sl_prev=0,sl_cur=0,sl_next=SLOTB;
  #define ROT() do{sl_prev=sl_cur;sl_cur=sl_next;sl_next=(sl_next==(NSLOT-1)*SLOTB)?0:sl_next+SLOTB;}while(0)
  DMA_K(2,2*SLOTB);
  WAIT_BAR(3);
  KBLD(0);
  qkt(pA0,pA1,Kbase,qr,r32,hi,KBF(kbn0),KBF(kbn1),qone); KBLD(1);asm volatile("s_nop 15\n\ts_nop 7":"+v"(pA0),"+v"(pA1));CMASK(pA0,pA1,0);
  START(pA0,pA1);
  _Pragma("unroll") for(int r=0;r<16;++r)pA1[r]=__builtin_amdgcn_exp2f(pA1[r]);
  WAIT_BAR(0);
  DMA_K(3,0);DMA_V(1,SLOTB);
  ROT();
  kload8(kf,kp0+sl_cur);
  WAIT_BAR(2);
  s16x4 vlo[8],vhi[8]; u32x4 pw0,pw1,pw2,pw3;
  #define PKW(P,B) cvtpk_s(P[B],P[B+1])
  #define PAF(k) __builtin_bit_cast(bf16x8,pw##k)
  #define VFR(i) (bf16x8){vlo[i][0],vlo[i][1],vlo[i][2],vlo[i][3],vhi[i][0],vhi[i][1],vhi[i][2],vhi[i][3]}
  #define PIN(x) asm volatile("":"+v"(x))
  #define MX3(a,b,c) __builtin_fmaxf(__builtin_fmaxf((a),(b)),(c))
  #define GAPA(MF,A0,A1,A2,A3,W0,W1,PW) do{ MF; sacc+=A0; sacc+=A1; sacc+=A2; sacc+=A3; PIN(sacc); W0; W1; PIN(PW); SBAR(); }while(0)
  #define EX(v) __builtin_amdgcn_exp2f(v)
  #define GAPB(MF,X,B) do{ MF; X[B]=EX(X[B]); X[B+1]=EX(X[B+1]); X[B+2]=EX(X[B+2]); X[B+3]=EX(X[B+3]); PIN(X); SBAR(); }while(0)
  #define VRD(i) do{ vlo[i]=vtr(vp_+(((i)>>2)*4096+((i)&3)*1024)); vhi[i]=vtr(vp_+(((i)>>2)*4096+((i)&3)*1024+512)); }while(0)
  #define KRD(G,j) do{ if(G){ kload2(kf,kp0+sl_next,j); SBAR(); } }while(0)
  #define STEP(C0,C1,P0,P1,t,GK,GV,GL) do{ SBAR(); \
    const lds_cptr vp_=vp0+sl_prev; \
    C0=__builtin_amdgcn_mfma_f32_32x32x16_bf16(KBF(kbn0),qone,f32x16{},0,0,0); C1=__builtin_amdgcn_mfma_f32_32x32x16_bf16(KBF(kbn1),qone,f32x16{},0,0,0); SBAR(); \
    VRD(0); SBAR(); float sacc=(P0[0]+P0[1]); \
    GAPA(C0=__builtin_amdgcn_mfma_f32_32x32x16_bf16(kf[0],qr[0],C0,0,0,0), P0[2],P0[3],P0[4],P0[5],     pw0[0]=PKW(P0,0), pw0[1]=PKW(P0,2), pw0); \
    VRD(4); SBAR(); GAPA(C1=__builtin_amdgcn_mfma_f32_32x32x16_bf16(kf[1],qr[0],C1,0,0,0), P0[6],P0[7],P0[8],P0[9],     pw0[2]=PKW(P0,4), pw0[3]=PKW(P0,6), pw0); \
    VRD(1); SBAR(); GAPA(C0=__builtin_amdgcn_mfma_f32_32x32x16_bf16(kf[2],qr[1],C0,0,0,0),   P0[10],P0[11],P0[12],P0[13], pw1[0]=PKW(P0,8), pw1[1]=PKW(P0,10), pw1); \
    VRD(5); SBAR(); GAPA(C1=__builtin_amdgcn_mfma_f32_32x32x16_bf16(kf[3],qr[1],C1,0,0,0),   P0[14],P0[15],P1[0],P1[1],   pw1[2]=PKW(P0,12),pw1[3]=PKW(P0,14), pw1); \
    VRD(2); SBAR(); GAPA(C0=__builtin_amdgcn_mfma_f32_32x32x16_bf16(kf[4],qr[2],C0,0,0,0),   P1[2],P1[3],P1[4],P1[5],     pw2[0]=PKW(P1,0), pw2[1]=PKW(P1,2), pw2); \
    VRD(6); SBAR(); GAPA(C1=__builtin_amdgcn_mfma_f32_32x32x16_bf16(kf[5],qr[2],C1,0,0,0),   P1[6],P1[7],P1[8],P1[9],     pw2[2]=PKW(P1,4), pw2[3]=PKW(P1,6), pw2); \
    VRD(3); SBAR(); GAPA(C0=__builtin_amdgcn_mfma_f32_32x32x16_bf16(kf[6],qr[3],C0,0,0,0),   P1[10],P1[11],P1[12],P1[13], pw3[0]=PKW(P1,8), pw3[1]=PKW(P1,10), pw3); \
    VRD(7); SBAR(); GAPA(C1=__builtin_amdgcn_mfma_f32_32x32x16_bf16(kf[7],qr[3],C1,0,0,0),   P1[14],P1[15],0.f,0.f,       pw3[2]=PKW(P1,12),pw3[3]=PKW(P1,14), pw3); \
    l_reg+=sacc; \
    if(GK){DMA_K((t)+3,sl_cur);} if(GV){DMA_V((t)+1,sl_next);} \
    CMASK(C0,C1,t); \
    { float a=MX3(C0[0],C0[1],C1[0]),b=MX3(C0[2],C0[3],C1[1]); a=MX3(a,C1[2],C1[3]); \
      _Pragma("unroll") for(int r=4;r<16;r+=4){a=MX3(a,C0[r],C0[r+1]);b=MX3(b,C0[r+2],C0[r+3]);a=MX3(a,C1[r],C1[r+1]);b=MX3(b,C1[r+2],C1[r+3]);} \
      float rm=__builtin_fmaxf(a,b); { auto rr=__builtin_amdgcn_permlane32_swap(__float_as_uint(rm),__float_as_uint(rm),false,false); rm=__builtin_fmaxf(__uint_as_float(rr[0]),__uint_as_float(rr[1])); } \
      resc=false; \
      if(__builtin_expect(__any(rm>(float)THRL),0)){ const float dl=__builtin_fmaxf(rm,0.f); mhat+=dl; \
        _Pragma("unroll") for(int r=0;r<16;++r){C0[r]-=dl;C1[r]-=dl;} \
        SETNEG(*cqs-mhat); \
        const float f=__builtin_amdgcn_exp2f(-dl); l_reg*=f; if(hi==0)wsf[r32]=f; resc=true; } } \
    SBAR(); \
    GAPB(o[0]=__builtin_amdgcn_mfma_f32_32x32x16_bf16(PAF(0),VFR(0),o[0],0,0,0), C0,0); \
    GAPB(o[1]=__builtin_amdgcn_mfma_f32_32x32x16_bf16(PAF(0),VFR(4),o[1],0,0,0), C0,4); \
    if(GL){KBLD((t)+1);} KRD(GL,0); GAPB(o[0]=__builtin_amdgcn_mfma_f32_32x32x16_bf16(PAF(1),VFR(1),o[0],0,0,0), C0,8); \
    KRD(GL,1); GAPB(o[1]=__builtin_amdgcn_mfma_f32_32x32x16_bf16(PAF(1),VFR(5),o[1],0,0,0), C0,12); \
    KRD(GL,2); GAPB(o[0]=__builtin_amdgcn_mfma_f32_32x32x16_bf16(PAF(2),VFR(2),o[0],0,0,0), C1,0); \
    KRD(GL,3); GAPB(o[1]=__builtin_amdgcn_mfma_f32_32x32x16_bf16(PAF(2),VFR(6),o[1],0,0,0), C1,4); \
    GAPB(o[0]=__builtin_amdgcn_mfma_f32_32x32x16_bf16(PAF(3),VFR(3),o[0],0,0,0), C1,8); \
    GAPB(o[1]=__builtin_amdgcn_mfma_f32_32x32x16_bf16(PAF(3),VFR(7),o[1],0,0,0), C1,12); \
    }while(0)
  int t=1;
  #undef CMASK
  #define CMASK(P0,P1,t) do{}while(0)
  for(;t+5<NT;t+=2){
    STEP(pB0,pB1,pA0,pA1,t,true,true,true);     WAIT_BAR(2); RESC(); ROT();
    STEP(pA0,pA1,pB0,pB1,t+1,true,true,true);   WAIT_BAR(2); RESC(); ROT();
  }
  #undef CMASK
  #define CMASK(P0,P1,t) do{int jb_=(t)-(NT-4); if(jb_>=0)cmask(P0,P1,jb_,qrel,hi);}while(0)
  #define ENDW(tt) do{ if((tt)+3<NT){WAIT_BAR(2);} else if((tt)+2<NT){WAIT_BAR(1);} else {WAIT_BAR(0);} }while(0)
  for(;t+1<NT;t+=2){
    STEP(pB0,pB1,pA0,pA1,t,(t+3<NT),(t+1<NT),(t+1<NT));       ENDW(t);   RESC(); ROT();
    STEP(pA0,pA1,pB0,pB1,t+1,(t+4<NT),(t+2<NT),(t+2<NT));     ENDW(t+1); RESC(); ROT();
  }
  STEP(pB0,pB1,pA0,pA1,NT-1,false,false,false); RESC();
  { float sacc=pB0[0]+pB0[1]; _Pragma("unroll") for(int r=2;r<16;++r)sacc+=pB0[r]; _Pragma("unroll") for(int r=0;r<16;++r)sacc+=pB1[r]; l_reg+=sacc;
    pw0=(u32x4){PKW(pB0,0),PKW(pB0,2),PKW(pB0,4),PKW(pB0,6)};pw1=(u32x4){PKW(pB0,8),PKW(pB0,10),PKW(pB0,12),PKW(pB0,14)};pw2=(u32x4){PKW(pB1,0),PKW(pB1,2),PKW(pB1,4),PKW(pB1,6)};pw3=(u32x4){PKW(pB1,8),PKW(pB1,10),PKW(pB1,12),PKW(pB1,14)};
    const int vb0=(int)(lds0+LDS_V)+((lane>>4)&1)*32+(lane&3)*8+(4*hi+((lane&15)>>2))*64;
    SBAR(); pv(o,vb0+sl_cur,PAF(0),PAF(1),PAF(2),PAF(3)); }
  #undef PKW
  #undef PAF
  #undef VFR
  #undef PIN
  #undef MX3
  #undef GAPA
  #undef GAPB
  #undef EX
  #undef VRD
  #undef KRD
  #undef STEP
  #undef ENDW
  {auto rr=__builtin_amdgcn_permlane32_swap(__float_as_uint(l_reg),__float_as_uint(l_reg),false,false);l_reg=__uint_as_float(rr[0])+__uint_as_float(rr[1]);}
  if(hi==0)wsf[32+r32]=l_reg;asm volatile("s_waitcnt lgkmcnt(0)":::"memory");
  float rli[16];
  #pragma unroll
  for(int r=0;r<16;++r)rli[r]=__builtin_amdgcn_rcpf(wsf[32+crow(r,hi)]);
  bf16*Ow=O+(rowbase+q0+wid*QBLK)*DM+h*D;
  { bf16*stg=(bf16*)(shm+LDS_OST)+wid*2048;
    #pragma unroll
    for(int r=0;r<16;++r){const int orow=crow(r,hi);
      #pragma unroll
      for(int d0=0;d0<2;++d0)stg[orow*64+d0*32+r32]=__float2bfloat16(o[d0][r]*rli[r]);}
    asm volatile("s_waitcnt lgkmcnt(0)":::"memory");
    #pragma unroll
    for(int i=0;i<4;++i){const int row=i*8+(lane>>3),ch=lane&7; const u32x4 v=*(const u32x4*)(stg+row*64+ch*8); if(dostore)ATTN_STORE16(Ow+(long)row*DM+ch*8,v);} }
  asm volatile("s_waitcnt lgkmcnt(0)\n\ts_barrier":::"memory");
  #undef DMA_K
  #undef KBLD
  #undef KBF
  #undef SETNEG
  #undef qone
  #undef DMA_V
  #undef CMASK
  #undef START
  #undef RESC
  #undef ROT
}
constexpr int ATTN_LDS_BYTES=LDS_TOTAL;
#undef SBAR
#undef WAIT_BAR
}

struct Args { const float* in[19]; float* out; unsigned char* ws; int ph; int pad; };
struct Frame {
    LAS unsigned char* lds;
    int tid, lane, wave, G, wave0;
    const float* in[19]; float* out; unsigned char* ws;
};
enum { I_X = 0, I_P, I_GMIX, I_WIN, I_LBL, I_ONG, I_FBIAS, I_QG, I_KG, I_WA, I_WB, I_WOUT, I_GFFN, I_WG, I_WU, I_WD, I_GPLE, I_WPG, I_WPP };

__device__ __forceinline__ void p0_tr_item(const float* W, int Nsrc, int K, bf16_t* WT, int dst_row0, int src_col0, int k0, const float* gain, LAS float* scr, int lane) {
    float tv[32];
#pragma unroll
    for (int i = 0; i < 32; ++i) { const int kk = 2 * i + (lane >> 5); tv[i] = __builtin_nontemporal_load(W + (size_t)(k0 + kk) * Nsrc + src_col0 + (lane & 31)); }
    if (gain) {
#pragma unroll
        for (int i = 0; i < 32; ++i) tv[i] *= gain[k0 + 2 * i + (lane >> 5)]; }
#pragma unroll
    for (int i = 0; i < 32; ++i) scr[(2 * i + (lane >> 5)) * 33 + (lane & 31)] = tv[i];
    LDS_WAIT(); asm volatile("" ::: "memory");
    const int c = lane & 7;
#pragma unroll
    for (int j = 0; j < 4; ++j) { const int n = (lane >> 3) + 8 * j; const LAS float* s = scr + (8 * c) * 33 + n;
        u32x4 o; o.x = pk2(s[0 * 33], s[1 * 33]); o.y = pk2(s[2 * 33], s[3 * 33]); o.z = pk2(s[4 * 33], s[5 * 33]); o.w = pk2(s[6 * 33], s[7 * 33]);
        *(u32x4*)(WT + (size_t)(dst_row0 + n) * K + k0 + 8 * c) = o; }
    LDS_WAIT(); asm volatile("" ::: "memory");
}
__device__ __forceinline__ float log_sigmoid(float v) { return v < 0.f ? v - log1pf(expf(v)) : -log1pf(expf(-v)); }

__device__ __forceinline__ void p0_prologue(Frame& F) {
    LAS float* scr = (LAS float*)(F.lds + F.wave * 16384);
    const int gw = blockIdx.x * NWAVES + F.wave, NGW = F.G * NWAVES;
    unsigned char* ws = F.ws;
    constexpr int IT0 = 16 * 176, IT1 = 8 * 32, IT2 = 8 * 32, IT3 = 16 * 32, IT4 = 16 * 176, IT5 = 44 * 32, IT6 = 16 * 32, IT7 = 4 * 32;
    constexpr int NITEMS = IT0 + IT1 + IT2 + IT3 + IT4 + IT5 + IT6 + IT7;
    for (int it = gw; it < NITEMS; it += NGW) {
        int r = it;
        if (r < IT0) { const int kb = r / 176, nb = r % 176, n0 = nb * 32, pn = n0 >> 8, rho = n0 & 255;
            int zc = n0; if (pn >= 8 && pn < 12) { const int bj = rho >> 7, wc = (rho >> 5) & 3; zc = pn * 256 + 64 * wc + 32 * bj; }
            const int src = zc < ZC_GA ? zc : zc + 8;
            p0_tr_item(F.in[I_WIN], INC, 1024, (bf16_t*)(ws + WS_WIN), n0, src, kb * 64, F.in[I_GMIX], scr, F.lane); continue; } r -= IT0;
        if (r < IT1) { p0_tr_item(F.in[I_WA], 1024, 512, (bf16_t*)(ws + WS_WA), (r % 32) * 32, (r % 32) * 32, (r / 32) * 64, nullptr, scr, F.lane); continue; } r -= IT1;
        if (r < IT2) { p0_tr_item(F.in[I_WB], 1024, 512, (bf16_t*)(ws + WS_WB), (r % 32) * 32, (r % 32) * 32, (r / 32) * 64, nullptr, scr, F.lane); continue; } r -= IT2;
        if (r < IT3) { p0_tr_item(F.in[I_WOUT], 1024, 1024, (bf16_t*)(ws + WS_WOUT), (r % 32) * 32, (r % 32) * 32, (r / 32) * 64, nullptr, scr, F.lane); continue; } r -= IT3;
        if (r < IT4) { const int kb = r / 176, nb = r % 176, n0 = nb * 32, pn = n0 >> 8, rho = n0 & 255, bj = rho >> 7, hid = pn * 128 + (rho & 127);
            p0_tr_item(bj ? F.in[I_WU] : F.in[I_WG], DFF, 1024, (bf16_t*)(ws + WS_WGU), n0, hid, kb * 64, F.in[I_GFFN], scr, F.lane); continue; } r -= IT4;
        if (r < IT5) { p0_tr_item(F.in[I_WD], 1024, DFF, (bf16_t*)(ws + WS_WD), (r % 32) * 32, (r % 32) * 32, (r / 32) * 64, nullptr, scr, F.lane); continue; } r -= IT5;
        if (r < IT6) { p0_tr_item(F.in[I_WPG], 1024, 1024, (bf16_t*)(ws + WS_WPG), (r % 32) * 32, (r % 32) * 32, (r / 32) * 64, F.in[I_GPLE], scr, F.lane); continue; } r -= IT6;
        p0_tr_item(F.in[I_WPP], 1024, PLE, (bf16_t*)(ws + WS_WPP), (r % 32) * 32, (r % 32) * 32, (r / 32) * 64, nullptr, scr, F.lane);
    }
    __syncthreads();
    LAS float* wf = (LAS float*)F.lds;
    for (int idx = F.tid; idx < 2048; idx += NTHR) { const int k = idx >> 1, half = idx & 1;
        f32x4 w = *(const f32x4*)(F.in[I_WIN] + (size_t)k * INC + ZC_GA + 4 * half); const float gk = F.in[I_GMIX][k]; w = w * gk;
        const int l = (k & 255) >> 2, e = k & 3, j = k >> 8; *(LAS f32x4*)(wf + (((j * 4 + e) * 64 + l) * 8 + 4 * half)) = w; }
    __syncthreads();
    const float* x = F.in[I_X]; bf16_t* xb = (bf16_t*)(ws + WS_XB); float* rstd = (float*)(ws + WS_RSTD); float* lf = (float*)(ws + WS_LF);
    f32x4 vn[4];
    { const f32x4* xr0 = (const f32x4*)(x + (size_t)(gw < M ? gw : 0) * DMODEL) + F.lane;
#pragma unroll
      for (int j = 0; j < 4; ++j) vn[j] = __builtin_nontemporal_load(xr0 + 64 * j); }
    for (int mrow = gw; mrow < M; mrow += NGW) {
        f32x4 v[4]; float ss = 0.f; float a[8];
#pragma unroll
        for (int j = 0; j < 4; ++j) v[j] = vn[j];
        { const int nrow = mrow + NGW < M ? mrow + NGW : mrow; const f32x4* xr1 = (const f32x4*)(x + (size_t)nrow * DMODEL) + F.lane;
#pragma unroll
          for (int j = 0; j < 4; ++j) vn[j] = __builtin_nontemporal_load(xr1 + 64 * j); }
#pragma unroll
        for (int h = 0; h < 8; ++h) a[h] = 0.f;
#pragma unroll
        for (int j = 0; j < 4; ++j) { ss += (v[j][0] * v[j][0] + v[j][1] * v[j][1]) + (v[j][2] * v[j][2] + v[j][3] * v[j][3]); }
#pragma unroll
        for (int j = 0; j < 4; ++j)
#pragma unroll
            for (int e = 0; e < 4; ++e) { const LAS f32x4* wp = (const LAS f32x4*)(wf + ((j * 4 + e) * 64 + F.lane) * 8); const f32x4 w0 = wp[0], w1 = wp[1]; const float xv = v[j][e];
#pragma unroll
                for (int h = 0; h < 4; ++h) { a[h] += xv * w0[h]; a[4 + h] += xv * w1[h]; } }
        ss = wave_sum(ss);
        const float rs = 1.0f / sqrtf(ss * (1.0f / DMODEL) + EPS);
#pragma unroll
        for (int h = 0; h < 8; ++h) a[h] = wave_sum(a[h]);
        unsigned long long* o8 = (unsigned long long*)(xb + (size_t)mrow * DMODEL) + F.lane;
#pragma unroll
        for (int j = 0; j < 4; ++j) o8[64 * j] = (unsigned long long)pk2(v[j][0] * rs, v[j][1] * rs) | ((unsigned long long)pk2(v[j][2] * rs, v[j][3] * rs) << 32);
        if (F.lane == 0) rstd[mrow] = rs;
        if (F.lane < 8) {
            float av = a[0];
#pragma unroll
            for (int h = 1; h < 8; ++h) av = (F.lane == h) ? a[h] : av;
            const float z = av * rs + F.in[I_FBIAS][F.lane];
            const int b = mrow >> 12, s = mrow & 4095;
            lf[(size_t)(b * 8 + F.lane) * SEQ + s] = log_sigmoid(z);
        }
    }
    { const float* p = F.in[I_P]; bf16_t* pb = (bf16_t*)(ws + WS_PB); const int gt = blockIdx.x * NTHR + F.tid, NT = F.G * NTHR;
#pragma unroll 4
      for (int i = gt; i < M * PLE / 8; i += NT) { const f32x4 a0 = __builtin_nontemporal_load((const f32x4*)(p + (size_t)i * 8)), a1 = __builtin_nontemporal_load((const f32x4*)(p + (size_t)i * 8 + 4));
          u32x4 w; w.x = pk2(a0[0], a0[1]); w.y = pk2(a0[2], a0[3]); w.z = pk2(a1[0], a1[1]); w.w = pk2(a1[2], a1[3]); *(u32x4*)(pb + (size_t)i * 8) = w; } }
}

__device__ __forceinline__ void fox_scan(Frame& F) {
    if (blockIdx.x >= 64) return;
    const int bh = blockIdx.x; const float* lf = (const float*)(F.ws + WS_LF) + (size_t)bh * SEQ; double* cd = (double*)(F.ws + WS_CD) + (size_t)bh * SEQ;
    LAS double* wtot = (LAS double*)F.lds;
    double loc[8]; double run = 0.0;
    { const f32x4 a0 = *(const f32x4*)(lf + F.tid * 8), a1 = *(const f32x4*)(lf + F.tid * 8 + 4);
#pragma unroll
      for (int j = 0; j < 4; ++j) { run += (double)a0[j]; loc[j] = run; }
#pragma unroll
      for (int j = 0; j < 4; ++j) { run += (double)a1[j]; loc[4 + j] = run; } }
    double inc = run;
#pragma unroll
    for (int o = 1; o < 64; o <<= 1) { const double t = __shfl_up(inc, o); if (F.lane >= o) inc += t; }
    if (F.lane == 63) wtot[F.wave] = inc;
    __syncthreads();
    double base = inc - run;
    for (int w = 0; w < F.wave; ++w) base += wtot[w];
#pragma unroll
    for (int j = 0; j < 8; ++j) cd[F.tid * 8 + j] = base + loc[j];
    LAS double* tend = wtot + 8; LAS double* qc = tend + 64;
    if ((F.tid & 7) == 7) tend[F.tid >> 3] = base + loc[7];
    if ((F.tid & 31) == 0) qc[F.tid >> 5] = base + loc[0];
    __syncthreads();
    if (F.tid < 16) { const int qb = F.tid; int cnt = 0; const double c0 = qc[qb];
        for (int t = 0; t < 4 * qb; ++t) { if (tend[t] - c0 >= 66.0 / 1.4426950408889634) cnt = t + 1; else break; }
        ((int*)(F.ws + WS_T0))[bh * 16 + qb] = cnt & ~1; }
    __syncthreads();
}

namespace hg {
constexpr int RAWQ = 0, RAWF = 16384, RAWV = 32768, RAWG = 49152, QT = 65536, KT = QT + 17408, KPT = KT + 17408, AS = KPT + 18432, DL = AS + 9216, TOT = DL + 512, SSQ = TOT + 2048, END = SSQ + 2048;
constexpr int QP = 272, AP = 144;
typedef short v4i16_t __attribute__((ext_vector_type(4)));
#define HBAR() do { asm volatile("s_waitcnt lgkmcnt(0)" ::: "memory"); __builtin_amdgcn_s_barrier(); asm volatile("" ::: "memory"); } while (0)
__device__ __forceinline__ unsigned cvtpk(float lo, float hi) { typedef float f2 __attribute__((ext_vector_type(2))); typedef __bf16 b2 __attribute__((ext_vector_type(2))); f2 v = {lo, hi}; b2 b = __builtin_convertvector(v, b2); return __builtin_bit_cast(unsigned, b); }
__device__ __forceinline__ float ex2(float x) { return __builtin_amdgcn_exp2f(x); }
#define HSB() __builtin_amdgcn_sched_barrier(0)

constexpr int NSEG = 4, CPS = 64 / NSEG;
template <bool FULL> __device__ __forceinline__ void hgrn_unit(int wave_s, bool dostore, int bh, int seg, bf16_t* Z, const float* og, unsigned char* wsb, LAS unsigned char* lds) {
    const int tid = fresh_tid(wave_s);
    const int lane = tid & 63, w = __builtin_amdgcn_readfirstlane(tid >> 6), l15 = lane & 15, g = lane >> 4;
    const int b = bh >> 2, h = bh & 3;
    bf16_t* zb = Z + (size_t)b * SEQ * ZLD + 128 * h;
    if constexpr (FULL) { for (int i = tid; i < 9216 / 4; i += NTHR) ((LAS unsigned*)(lds + AS))[i] = 0u; }
    float* const Ug = (float*)(wsb + WS_HGU); float* const LBg = (float*)(wsb + WS_HGLB); unsigned* const done = (unsigned*)(wsb + WS_CTL) + 256 + 64 * bh;
    const int c0 = seg * CPS, c1 = c0 + CPS;
    f32x4 Sacc[8];
#pragma unroll
    for (int i = 0; i < 8; ++i) Sacc[i] = (f32x4){0.f, 0.f, 0.f, 0.f};
    u32x4 pre[8];
    const int prow = tid >> 4, pch = tid & 15;
#define HG_PREFETCH(c) do { const int cc_ = (c) < c1 ? (c) : c1 - 1; const bf16_t* p_ = zb + (size_t)(cc_ * 64 + prow) * ZLD + pch * 8; \
        _Pragma("unroll") for (int X = 0; X < 4; ++X) if (FULL || X == 1 || X == 2) { pre[2 * X] = *(const u32x4*)(p_ + X * 512); pre[2 * X + 1] = *(const u32x4*)(p_ + (size_t)32 * ZLD + X * 512); } } while (0)
#define HG_STAGE() do { _Pragma("unroll") for (int X = 0; X < 4; ++X) if (FULL || X == 1 || X == 2) { *(LAS u32x4*)(lds + X * 16384 + prow * 256 + pch * 16) = pre[2 * X]; *(LAS u32x4*)(lds + X * 16384 + (prow + 32) * 256 + pch * 16) = pre[2 * X + 1]; } } while (0)
    const int kk = (w & 1) * 64 + lane, tg = w >> 1;
    if (FULL && seg > 0) {
        if (tid == 0) { while (__hip_atomic_load(done, __ATOMIC_RELAXED, __HIP_MEMORY_SCOPE_AGENT) < (unsigned)(NSEG - 1)) __builtin_amdgcn_s_sleep(2);
            __builtin_amdgcn_fence(__ATOMIC_ACQUIRE, "agent"); asm volatile("s_waitcnt vmcnt(0)" ::: "memory"); }
        __syncthreads();
        for (int j = 0; j < seg; ++j) {
            const float* Uj = Ug + ((size_t)((bh * (NSEG - 1) + j) * 8 + w) * 8) * 256; const float* Lj = LBg + (bh * (NSEG - 1) + j) * 128;
#pragma unroll
            for (int kt = 0; kt < 8; ++kt) { const f32x4 u = *(const f32x4*)(Uj + kt * 256 + lane * 4); const f32x4 l4 = *(const f32x4*)(Lj + 16 * kt + 4 * g);
#pragma unroll
                for (int r = 0; r < 4; ++r) Sacc[kt][r] = Sacc[kt][r] * ex2(l4[r] * LOG2E) + u[r]; }
        }
    }
    HG_PREFETCH(c0); HG_STAGE(); HG_PREFETCH(c0 + 1);
    const float gain = og[16 * w + l15];
    float bsum = 0.f;
    for (int c = c0; c < c1; ++c) {
        HBAR();
        float bl[16], qv[16];
        { bf16_t fr_[16], qr_[16];
#pragma unroll
          for (int i = 0; i < 16; ++i) { fr_[i] = *(const LAS bf16_t*)(lds + RAWF + (16 * tg + i) * 256 + kk * 2); qr_[i] = FULL ? *(const LAS bf16_t*)(lds + RAWQ + (16 * tg + i) * 256 + kk * 2) : (bf16_t)0; }
          HSB();
          float run = 0.f;
#pragma unroll
          for (int i = 0; i < 16; ++i) { run += bf1(fr_[i]); bl[i] = run; qv[i] = bf1(qr_[i]); }
          ((LAS float*)(lds + TOT))[tg * 128 + kk] = run; }
        HBAR();
        { const LAS float* tp = (const LAS float*)(lds + TOT) + kk; const float t0 = tp[0], t1 = tp[128], t2 = tp[256], t3 = tp[384];
          HSB();
          const float prefix = (tg > 0 ? t0 : 0.f) + (tg > 1 ? t1 : 0.f) + (tg > 2 ? t2 : 0.f); const float blast = (t0 + t1) + (t2 + t3);
          const float dlv = ex2(blast * LOG2E); bsum += blast;
          unsigned kp[8], wq[16]; float prevb = 0.f, kprev = 0.f;
#pragma unroll
          for (int i = 0; i < 16; ++i) {
              const float lfv = bl[i] - prevb; prevb = bl[i];
              const float bt = prefix + bl[i];
              const float f = ex2(lfv * LOG2E), kf = 1.0f - f;
              const float enb = ex2(-bt * LOG2E);
              if constexpr (FULL) { const float eb = ex2(bt * LOG2E); wq[i] = cvtpk(qv[i] * eb, kf * enb); } else wq[i] = 0u;
              const float kpv = kf * enb * dlv;
              if (i & 1) kp[i >> 1] = cvtpk(kprev, kpv); else kprev = kpv;
          }
          HSB();
          if (tg == 0) ((LAS float*)(lds + DL))[kk] = dlv;
          if constexpr (FULL) {
#pragma unroll
          for (int i = 0; i < 16; ++i) { const int t = 16 * tg + i;
              *(LAS bf16_t*)(lds + QT + t * QP + kk * 2) = (bf16_t)(wq[i] & 0xffffu);
              *(LAS bf16_t*)(lds + KT + t * QP + kk * 2) = (bf16_t)(wq[i] >> 16); } }
          *(LAS u32x4*)(lds + KPT + kk * AP + (16 * tg) * 2) = (u32x4){kp[0], kp[1], kp[2], kp[3]};
          *(LAS u32x4*)(lds + KPT + kk * AP + (16 * tg) * 2 + 16) = (u32x4){kp[4], kp[5], kp[6], kp[7]}; }
        HBAR();
#define HG_ASTILE(ti, tj) do { f32x4 d_ = (f32x4){0.f, 0.f, 0.f, 0.f}; bf16x8 a_[4], b_[4]; \
            _Pragma("unroll") for (int ks = 0; ks < 4; ++ks) { a_[ks] = *(const LAS bf16x8*)(lds + QT + (16 * (ti) + l15) * QP + (32 * ks + 8 * g) * 2); \
                b_[ks] = *(const LAS bf16x8*)(lds + KT + (16 * (tj) + l15) * QP + (32 * ks + 8 * g) * 2); } \
            HSB(); \
            _Pragma("unroll") for (int ks = 0; ks < 4; ++ks) d_ = __builtin_amdgcn_mfma_f32_16x16x32_bf16(a_[ks], b_[ks], d_, 0, 0, 0); \
            _Pragma("unroll") for (int r = 0; r < 4; r += 2) { const int t_ = 16 * (ti) + 4 * g + r, s_ = 16 * (tj) + l15; \
                const unsigned w_ = cvtpk(s_ <= t_ ? d_[r] : 0.f, s_ <= t_ + 1 ? d_[r + 1] : 0.f); \
                *(LAS bf16_t*)(lds + AS + t_ * AP + s_ * 2) = (bf16_t)(w_ & 0xffffu); *(LAS bf16_t*)(lds + AS + (t_ + 1) * AP + s_ * 2) = (bf16_t)(w_ >> 16); } HSB(); } while (0)
        if constexpr (FULL) {
        if (w == 0) { HG_ASTILE(0, 0); HG_ASTILE(3, 0); }
        else if (w == 1) { HG_ASTILE(1, 1); HG_ASTILE(3, 1); }
        else if (w == 2) { HG_ASTILE(2, 2); }
        else if (w == 3) { HG_ASTILE(3, 3); }
        else if (w == 4) { HG_ASTILE(1, 0); }
        else if (w == 5) { HG_ASTILE(2, 0); }
        else if (w == 6) { HG_ASTILE(2, 1); }
        else { HG_ASTILE(3, 2); }
        }
        bf16x8 vf[2]; f32x4 o[4];
        {
            v4i16_t vlo[2], vhi[2];
            const int q_ = l15 >> 2, p_ = lane & 3;
#pragma unroll
            for (int ts = 0; ts < 2; ++ts) {
                vlo[ts] = __builtin_amdgcn_ds_read_tr16_b64_v4i16((LAS v4i16_t*)(lds + RAWV + (32 * ts + 8 * g + q_) * 256 + (16 * w + 4 * p_) * 2));
                vhi[ts] = __builtin_amdgcn_ds_read_tr16_b64_v4i16((LAS v4i16_t*)(lds + RAWV + (32 * ts + 8 * g + 4 + q_) * 256 + (16 * w + 4 * p_) * 2)); }
#pragma unroll
            for (int mt = 0; mt < 4; ++mt) o[mt] = (f32x4){0.f, 0.f, 0.f, 0.f};
            if constexpr (FULL) {
#pragma unroll
            for (int kh = 0; kh < 2; ++kh) {
                u32x2 a0[2][4], a1[2][4];
#pragma unroll
                for (int k2 = 0; k2 < 2; ++k2)
#pragma unroll
                    for (int mt = 0; mt < 4; ++mt) { const int ks = 2 * kh + k2; a0[k2][mt] = *(const LAS u32x2*)(lds + QT + (16 * mt + l15) * QP + (32 * ks + 4 * g) * 2); a1[k2][mt] = *(const LAS u32x2*)(lds + QT + (16 * mt + l15) * QP + (32 * ks + 16 + 4 * g) * 2); }
                HSB();
#pragma unroll
                for (int k2 = 0; k2 < 2; ++k2) { const int ks = 2 * kh + k2;
                    const u32x4 sbw = (u32x4){cvtpk(Sacc[2 * ks][0], Sacc[2 * ks][1]), cvtpk(Sacc[2 * ks][2], Sacc[2 * ks][3]), cvtpk(Sacc[2 * ks + 1][0], Sacc[2 * ks + 1][1]), cvtpk(Sacc[2 * ks + 1][2], Sacc[2 * ks + 1][3])};
                    const bf16x8 sb = __builtin_bit_cast(bf16x8, sbw);
#pragma unroll
                    for (int mt = 0; mt < 4; ++mt) { const bf16x8 aq = __builtin_bit_cast(bf16x8, (u32x4){a0[k2][mt].x, a0[k2][mt].y, a1[k2][mt].x, a1[k2][mt].y});
                        o[mt] = __builtin_amdgcn_mfma_f32_16x16x32_bf16(aq, sb, o[mt], 0, 0, 0); } }
                HSB();
            }
            } else { HSB(); }
#pragma unroll
            for (int ts = 0; ts < 2; ++ts) vf[ts] = (bf16x8){vlo[ts][0], vlo[ts][1], vlo[ts][2], vlo[ts][3], vhi[ts][0], vhi[ts][1], vhi[ts][2], vhi[ts][3]};
        }
#pragma unroll
        for (int hb = 0; hb < 2; ++hb) {
            bf16x8 akp[4][2]; f32x4 dl4[4];
#pragma unroll
            for (int k4 = 0; k4 < 4; ++k4) { const int kt = 4 * hb + k4; dl4[k4] = *(const LAS f32x4*)(lds + DL + (16 * kt + 4 * g) * 4);
#pragma unroll
                for (int ts = 0; ts < 2; ++ts) akp[k4][ts] = *(const LAS bf16x8*)(lds + KPT + (16 * kt + l15) * AP + (32 * ts + 8 * g) * 2); }
            HSB();
#pragma unroll
            for (int ts = 0; ts < 2; ++ts)
#pragma unroll
                for (int k4 = 0; k4 < 4; ++k4) { const int kt = 4 * hb + k4; const f32x4 cin = ts == 0 ? Sacc[kt] * dl4[k4] : Sacc[kt];
                    Sacc[kt] = __builtin_amdgcn_mfma_f32_16x16x32_bf16(akp[k4][ts], vf[ts], cin, 0, 0, 0); }
            HSB();
        }
        float gv[4][4];
        if constexpr (FULL) {
        { bf16_t gr_[4][4];
#pragma unroll
          for (int mt = 0; mt < 4; ++mt)
#pragma unroll
              for (int r = 0; r < 4; ++r) gr_[mt][r] = *(const LAS bf16_t*)(lds + RAWG + (16 * mt + 4 * g + r) * 256 + (16 * w + l15) * 2);
          HSB();
#pragma unroll
          for (int mt = 0; mt < 4; ++mt)
#pragma unroll
              for (int r = 0; r < 4; ++r) gv[mt][r] = bf1(gr_[mt][r]); }
        HBAR();
        { bf16x8 aa[4][2];
#pragma unroll
          for (int mt = 0; mt < 4; ++mt)
#pragma unroll
              for (int ks = 0; ks < 2; ++ks) { if (ks == 1 && mt < 2) continue; aa[mt][ks] = *(const LAS bf16x8*)(lds + AS + (16 * mt + l15) * AP + (32 * ks + 8 * g) * 2); }
          HSB();
#pragma unroll
          for (int ks = 0; ks < 2; ++ks)
#pragma unroll
              for (int mt = 0; mt < 4; ++mt) { if (ks == 1 && mt < 2) continue; o[mt] = __builtin_amdgcn_mfma_f32_16x16x32_bf16(aa[mt][ks], vf[ks], o[mt], 0, 0, 0); }
          HSB(); }
#pragma unroll
        for (int mt = 0; mt < 4; ++mt)
#pragma unroll
            for (int r = 0; r < 4; ++r) { const float ss = row16_sum(o[mt][r] * o[mt][r]);
                if (l15 == 0) ((LAS float*)(lds + SSQ))[(16 * mt + 4 * g + r) * 8 + w] = ss; }
        }
        HBAR();
        HG_STAGE(); HG_PREFETCH(c + 2);
        if constexpr (FULL) {
        bf16_t* yb = zb + (size_t)(c * 64) * ZLD + ZC_I + 16 * w + l15;
#pragma unroll
        for (int mt = 0; mt < 4; ++mt) { f32x4 s0[4], s1[4];
#pragma unroll
            for (int r = 0; r < 4; ++r) { const LAS f32x4* sp = (const LAS f32x4*)(lds + SSQ + (16 * mt + 4 * g + r) * 32); s0[r] = sp[0]; s1[r] = sp[1]; }
            HSB();
#pragma unroll
            for (int r = 0; r < 4; ++r) { const int t = 16 * mt + 4 * g + r; const f32x4 u0 = s0[r], u1 = s1[r];
                const float tot = ((u0[0] + u0[1]) + (u0[2] + u0[3])) + ((u1[0] + u1[1]) + (u1[2] + u1[3]));
                const float rs = __builtin_amdgcn_rsqf(tot * (1.0f / 128.0f) + EPS);
                if (dostore) yb[(size_t)t * ZLD] = (bf16_t)f2bf(o[mt][r] * rs * gain * gv[mt][r]); }
            HSB(); }
            }
}
    if constexpr (!FULL) {
        float* Uo = Ug + ((size_t)((bh * (NSEG - 1) + seg) * 8 + w) * 8) * 256;
#pragma unroll
        for (int kt = 0; kt < 8; ++kt) *(f32x4*)(Uo + kt * 256 + lane * 4) = Sacc[kt];
        if (tg == 0) LBg[(bh * (NSEG - 1) + seg) * 128 + kk] = bsum;
        asm volatile("s_waitcnt vmcnt(0)" ::: "memory");
        __syncthreads();
        if (tid == 0) { __builtin_amdgcn_fence(__ATOMIC_RELEASE, "agent"); asm volatile("s_waitcnt vmcnt(0)" ::: "memory"); __hip_atomic_fetch_add(done, 1u, __ATOMIC_RELAXED, __HIP_MEMORY_SCOPE_AGENT); }
    }
#undef HG_PREFETCH
#undef HG_STAGE
#undef HG_ASTILE
}
}

constexpr int QSLOT_OFF = LDS_BYTES - 64;
constexpr int N_P1 = 32 * (hg::NSEG - 1), N_S0 = 32, N_FOXA = 128, N_P2 = 32 * (hg::NSEG - 1), N_FOX = 64 * 16;
constexpr int N_ITEMS = N_P1 + N_S0 + N_P2 + N_FOX;
static_assert(hg::END <= QSLOT_OFF && attn_body::ATTN_LDS_BYTES <= QSLOT_OFF, "LDS map");
__device__ __forceinline__ void mix_phase(Frame& F, unsigned char* ldsg) {
    unsigned* ctr = (unsigned*)(F.ws + WS_CTL);
    LAS int* slot = (LAS int*)(F.lds + QSLOT_OFF);
    const attn_body::bf16* Zb = (const attn_body::bf16*)(F.ws + WS_Z);
    for (;;) {
        if (F.tid == 0) *slot = (int)atomicAdd(ctr, 1u);
        __syncthreads();
        const int item = __builtin_amdgcn_readfirstlane(*slot);
        __syncthreads();
        if (item >= N_ITEMS) break;
        int fox = -1;
        if (item < N_P1) hg::hgrn_unit<false>(F.wave0, true, item / (hg::NSEG - 1), item % (hg::NSEG - 1), (bf16_t*)(F.ws + WS_Z), F.in[I_ONG], F.ws, F.lds);
        else if (item < N_P1 + N_S0) hg::hgrn_unit<true>(F.wave0, true, item - N_P1, 0, (bf16_t*)(F.ws + WS_Z), F.in[I_ONG], F.ws, F.lds);
        else if (item < N_P1 + N_S0 + N_FOXA) fox = item - (N_P1 + N_S0);
        else if (item < N_P1 + N_S0 + N_FOXA + N_P2) { const int j = item - (N_P1 + N_S0 + N_FOXA); hg::hgrn_unit<true>(F.wave0, true, j / (hg::NSEG - 1), 1 + j % (hg::NSEG - 1), (bf16_t*)(F.ws + WS_Z), F.in[I_ONG], F.ws, F.lds); }
        else fox = item - (N_P1 + N_S0 + N_P2);
        if (fox >= 0) { const int qb = 15 - (fox >> 6), bh = fox & 63;
          attn_body::attn_unit<8>(F.wave0, true, bh >> 3, bh & 7, qb, __builtin_amdgcn_readfirstlane(((const int*)(F.ws + WS_T0))[bh * 16 + qb]), (const double*)(F.ws + WS_CD) + (size_t)bh * SEQ, Zb + ZC_FQ, Zb + ZC_FK, Zb + ZC_FV, (attn_body::bf16*)(Zb + ZC_FQ), (char*)ldsg); }
    }
}

#define XB_TMO      128
#define XB_XCNT(j)  (256  + 64 * (j))
#define XB_XSUB(j)  (1280 + 64 * (j))
#define XB_XGEN(j)  (2304 + 64 * (j))
#define XB_TOP      3328
#define XB_TOPGEN   3392
#define XB_SPIN_CAP (1u << 22)
__device__ __forceinline__ unsigned xb_ld(unsigned* p)              { return __hip_atomic_load(p, __ATOMIC_RELAXED, __HIP_MEMORY_SCOPE_AGENT); }
__device__ __forceinline__ unsigned xb_add(unsigned* p, unsigned v) { return __hip_atomic_fetch_add(p, v, __ATOMIC_RELAXED, __HIP_MEMORY_SCOPE_AGENT); }
__device__ __forceinline__ unsigned xb_xcc_id() { return (unsigned)__builtin_amdgcn_s_getreg((3 << 11) | 20) & 0xFu; }
#define XB_SPIN(cond, bar) do { unsigned _sp = 0; while (cond) { __builtin_amdgcn_s_sleep(1); \
    if ((++_sp & 255u) == 0u) { if (xb_ld(&(bar)[XB_TMO])) break; if (_sp > XB_SPIN_CAP) { atomicAdd(&(bar)[XB_TMO], 1u); break; } } } } while (0)
__device__ __forceinline__ void xcd_barrier_complete(unsigned* bar, unsigned x, unsigned G, unsigned& nloc, unsigned& nx) {
    unsigned sum, cnt, mine, sp = 0u;
    for (;;) {
        sum = 0u; cnt = 0u; mine = 0u;
#pragma unroll
        for (unsigned j = 0; j < 16; ++j) { const unsigned c = xb_ld(&bar[XB_XCNT(j)]); sum += c; cnt += (c > 0u) ? 1u : 0u; mine = (j == x) ? c : mine; }
        if (sum == G) break;
        __builtin_amdgcn_s_sleep(1);
        if ((++sp & 255u) == 0u) { if (xb_ld(&bar[XB_TMO])) break; if (sp > XB_SPIN_CAP) { atomicAdd(&bar[XB_TMO], 1u); break; } }
    }
    nloc = mine > 0u ? mine : 1u; nx = cnt > 0u ? cnt : 1u;
}
__device__ __forceinline__ void grid_barrier(Frame& F, unsigned* bar, int) {
    const int t = fresh_tid(F.wave0);
    volatile LAS unsigned* st = (volatile LAS unsigned*)(F.lds + QSLOT_OFF + 16);
    asm volatile("s_waitcnt vmcnt(0)" ::: "memory");
    __syncthreads();
    if (t == 0) {
        const unsigned x = xb_xcc_id();
        __builtin_amdgcn_s_waitcnt(0);
        unsigned nloc = st[0], nx = st[1];
        if (nloc == 0u) { xcd_barrier_complete(bar, x, (unsigned)F.G, nloc, nx); st[0] = nloc; st[1] = nx; }
        const unsigned old = xb_add(&bar[XB_XSUB(x)], 1u);
        const unsigned gen = old / nloc;
        if (old + 1u == (gen + 1u) * nloc) {
            __builtin_amdgcn_fence(__ATOMIC_RELEASE, "agent");
            asm volatile("s_waitcnt vmcnt(0)" ::: "memory");
            const unsigned og = xb_add(&bar[XB_TOP], 1u);
            const unsigned tg = og / nx;
            if (og + 1u == (tg + 1u) * nx) xb_add(&bar[XB_TOPGEN], 1u);
            else XB_SPIN(xb_ld(&bar[XB_TOPGEN]) == tg, bar);
            __builtin_amdgcn_fence(__ATOMIC_ACQUIRE, "agent");
            xb_add(&bar[XB_XGEN(x)], 1u);
            asm volatile("s_waitcnt vmcnt(0)" ::: "memory");
        } else {
            XB_SPIN(xb_ld(&bar[XB_XGEN(x)]) == gen, bar);
            __builtin_amdgcn_fence(__ATOMIC_ACQUIRE, "agent");
            asm volatile("s_waitcnt vmcnt(0)" ::: "memory");
        }
    }
    __syncthreads();
}
template <class Epi> __device__ __forceinline__ void run_gemm(Frame& F, const pg8::Gemm& g, const Epi& E) {
    pg8::StaticOrder S; S.init(g.M, g.N, F.G, (int)blockIdx.x);
    pg8::gemm_phase<Epi, true, true>(F.wave0, F.lds, g, S, E);
}

__global__ void __launch_bounds__(NTHR, 2) skel_fwd(Args args) {
    extern __shared__ __attribute__((aligned(16))) unsigned char lds[];
    Frame F;
    F.lds = (LAS unsigned char*)lds; F.tid = 0; F.lane = 0; F.wave = 0; F.G = gridDim.x; F.wave0 = __builtin_amdgcn_readfirstlane((int)threadIdx.x >> 6);
#pragma unroll
    for (int i = 0; i < 19; ++i) F.in[i] = args.in[i];
    F.out = args.out; F.ws = args.ws;
    unsigned char* ws = args.ws;
    bf16_t* Z = (bf16_t*)(ws + WS_Z); bf16_t* XB = (bf16_t*)(ws + WS_XB);
    const int ph = args.ph;
    int seam_no = 0; (void)seam_no;
#if ONE_LAUNCH
    { const int t0_ = fresh_tid(F.wave0); if (t0_ == 0) { volatile LAS unsigned* st = (volatile LAS unsigned*)(F.lds + QSLOT_OFF + 16); st[0] = 0u; st[1] = 0u; (void)xb_add((unsigned*)(ws + WS_CTL) + 8192 + XB_XCNT(xb_xcc_id()), 1u); } __syncthreads(); }
#endif
    if (ph == 0x7ffffff0) cg::this_grid().sync();
#define FRESH() do { const int t_ = fresh_tid(F.wave0); F.tid = t_; F.lane = t_ & 63; F.wave = __builtin_amdgcn_readfirstlane(t_ >> 6); } while (0)
#define IN(k) (ph < 0 || ph == (k))
#if ONE_LAUNCH
#define SEAM() grid_barrier(F, (unsigned*)(ws + WS_CTL) + 8192, seam_no++)
#else
#define SEAM() do {} while (0)
#endif
    if (IN(0)) { FRESH(); p0_prologue(F); SEAM(); }
    if (IN(1)) {
        FRESH(); fox_scan(F);
        pg8::Gemm g{XB, (const bf16_t*)(ws + WS_WIN), M, ZLD, 1024, 1024};
        pg8::EpiIn E{Z, (const float*)(ws + WS_RSTD), F.in[I_LBL], F.in[I_QG], F.in[I_KG]};
        run_gemm(F, g, E);
        SEAM();
    }
    if (IN(2)) {
        FRESH(); mix_phase(F, lds);
        SEAM();
    }
    if (IN(3)) {
        { pg8::Gemm g{Z + ZC_FQ, (const bf16_t*)(ws + WS_WB), M, 1024, 1024, ZLD, 512, Z + ZC_I, (const bf16_t*)(ws + WS_WA), 8};
          pg8::EpiGate E{XB, 1024, Z + ZC_GA, Z + ZC_GB, ZLD}; run_gemm(F, g, E); }
        SEAM();
    }
    if (IN(4)) {
        pg8::Gemm g{XB, (const bf16_t*)(ws + WS_WOUT), M, 1024, 1024, 1024};
        pg8::EpiResid<false> E{F.in[I_X], nullptr, (bf16_t*)(ws + WS_X1B), (float*)(ws + WS_SSQ1)};
        run_gemm(F, g, E); SEAM();
    }
    if (IN(5)) {
        pg8::Gemm g{(const bf16_t*)(ws + WS_X1B), (const bf16_t*)(ws + WS_WGU), M, 2 * DFF, 1024, 1024};
        pg8::EpiSwiglu E{(bf16_t*)(ws + WS_H), (const float*)(ws + WS_SSQ1)};
        run_gemm(F, g, E);
        SEAM();
    }
    if (IN(6)) {
        pg8::Gemm g{(const bf16_t*)(ws + WS_H), (const bf16_t*)(ws + WS_WD), M, 1024, DFF, DFF};
        pg8::EpiResid<true> E{nullptr, (const bf16_t*)(ws + WS_X1B), XB, (float*)(ws + WS_SSQ2)};
        run_gemm(F, g, E); SEAM();
    }
    if (IN(7)) {
        { pg8::Gemm g{(const bf16_t*)(ws + WS_PB), (const bf16_t*)(ws + WS_WPP), M, 1024, PLE, PLE}; pg8::EpiPlain E{(bf16_t*)(ws + WS_PP), 1024}; run_gemm(F, g, E); }
        { pg8::Gemm g{XB, (const bf16_t*)(ws + WS_WPG), M, 1024, 1024, 1024}; pg8::EpiPle E{F.out, XB, (const bf16_t*)(ws + WS_PP), (const float*)(ws + WS_SSQ2)}; run_gemm(F, g, E); }
    }
#undef IN
#undef SEAM
}

extern "C" void kernel_launch(void* const* d_in, const int* in_sizes, int n_in, void* d_out, int out_size, void* d_ws, size_t ws_size, hipStream_t stream) {
    static int grid = 0;
    if (grid == 0) {
        if (n_in != 19 || out_size != M * DMODEL || ws_size < WS_END) { fprintf(stderr, "kernel_launch: unexpected shapes (n_in %d out %d ws %zu)\n", n_in, out_size, ws_size); grid = -1; return; }
        int dev = 0, cus = 0, per_cu = 0;
        hipGetDevice(&dev); hipDeviceGetAttribute(&cus, hipDeviceAttributeMultiprocessorCount, dev);
        hipFuncSetAttribute((const void*)skel_fwd, hipFuncAttributeMaxDynamicSharedMemorySize, LDS_BYTES);
        hipOccupancyMaxActiveBlocksPerMultiprocessor(&per_cu, (const void*)skel_fwd, NTHR, LDS_BYTES);
        if (per_cu < 1) per_cu = 1;
        (void)hipGetLastError();
        grid = cus * per_cu;
    }
    if (grid < 0) return;
    hipMemsetAsync((char*)d_ws + WS_CTL, 0, CTL_ZERO_BYTES, stream);
    Args a{};
    for (int i = 0; i < 19; ++i) a.in[i] = (const float*)d_in[i];
    a.out = (float*)d_out; a.ws = (unsigned char*)d_ws;
#if ONE_LAUNCH
    a.ph = -1;
    void* kargs[] = {&a};
    hipError_t e = hipLaunchCooperativeKernel((const void*)skel_fwd, dim3(grid), dim3(NTHR), kargs, LDS_BYTES, stream);
    if (e != hipSuccess) fprintf(stderr, "cooperative launch failed: %s (grid %d)\n", hipGetErrorString(e), grid);
#else
    const int phases[] = {0, 1, 2, 3, 4, 5, 6, 7};
    for (int ph : phases) { a.ph = ph; hipLaunchKernelGGL(skel_fwd, dim3(grid), dim3(NTHR), LDS_BYTES, stream, a); }
#endif
}
```

```cpp
#include <hip/hip_runtime.h>
#include <hip/hip_cooperative_groups.h>
#include <cstdio>
#include <cstdint>
#include <cmath>
namespace cg = cooperative_groups;

#ifndef ONE_LAUNCH
#define ONE_LAUNCH 1
#endif

#define GAS __attribute__((address_space(1)))
#define LAS __attribute__((address_space(3)))
typedef unsigned short bf16_t;
typedef short bf16x8 __attribute__((ext_vector_type(8)));
typedef float f32x4 __attribute__((ext_vector_type(4)));
typedef float f32x2 __attribute__((ext_vector_type(2)));
typedef unsigned u32x4 __attribute__((ext_vector_type(4)));
typedef unsigned u32x2 __attribute__((ext_vector_type(2)));

constexpr int BATCH = 8, SEQ = 4096, DMODEL = 1024, M = BATCH * SEQ;
constexpr int INC = 5640, ZLD = 5632, DFF = 2816, PLE = 256;
constexpr int ZC_Q = 0, ZC_F = 512, ZC_I = 1024, ZC_G = 1536, ZC_FQ = 2048, ZC_FK = 2560, ZC_FV = 3072, ZC_GA = 3584, ZC_GB = 4608;
constexpr float EPS = 1e-6f;
constexpr float LOG2E = 1.4426950408889634f;
constexpr float C2 = 0.125f * 1.4426950408889634f;
constexpr int NWAVES = 8, NTHR = 512;

constexpr size_t MiB = 1u << 20;
constexpr size_t WS_CTL = 0, CTL_ZERO_BYTES = 1 * MiB;
constexpr size_t WS_WIN = 1 * MiB, WS_WA = 12 * MiB, WS_WB = 13 * MiB, WS_WOUT = 14 * MiB, WS_WGU = 16 * MiB, WS_WD = 27 * MiB, WS_WPG = 33 * MiB, WS_WPP = 35 * MiB;
constexpr size_t WS_T0 = 35 * MiB + 768 * 1024;
constexpr size_t WS_RSTD = 36 * MiB, WS_LF = 36 * MiB + 256 * 1024, WS_CD = 38 * MiB, WS_SSQ1 = 40 * MiB, WS_SSQ2 = 42 * MiB;
constexpr size_t WS_XB = 44 * MiB, WS_PB = 108 * MiB, WS_Z = 124 * MiB;
constexpr size_t WS_HGU = 476 * MiB, WS_HGLB = 484 * MiB;
constexpr size_t WS_X1B = WS_Z, WS_H = WS_Z + 64 * MiB, WS_PP = WS_Z + 240 * MiB, WS_END = WS_Z + 352 * MiB;
static_assert(WS_END <= WS_HGU && WS_HGLB + 65536 <= 512 * MiB, "ws map");
constexpr int LDS_BYTES = 155648;

__device__ __forceinline__ unsigned f2bf(float f) { unsigned u = __builtin_bit_cast(unsigned, f); return (u + 0x7fffu + ((u >> 16) & 1u)) >> 16; }
__device__ __forceinline__ unsigned pk2(float lo, float hi) { typedef float f2_ __attribute__((ext_vector_type(2))); typedef __bf16 b2_ __attribute__((ext_vector_type(2))); f2_ v = {lo, hi}; b2_ b = __builtin_convertvector(v, b2_); return __builtin_bit_cast(unsigned, b); }
__device__ __forceinline__ float bflo(unsigned w) { return __builtin_bit_cast(float, w << 16); }
__device__ __forceinline__ float bfhi(unsigned w) { return __builtin_bit_cast(float, w & 0xffff0000u); }
__device__ __forceinline__ float bf1(bf16_t h) { return __builtin_bit_cast(float, (unsigned)h << 16); }
__device__ __forceinline__ float row16_sum(float v) {
    v += __builtin_bit_cast(float, __builtin_amdgcn_update_dpp(0, __builtin_bit_cast(int, v), 0x128, 0xf, 0xf, false));
    v += __builtin_bit_cast(float, __builtin_amdgcn_update_dpp(0, __builtin_bit_cast(int, v), 0x124, 0xf, 0xf, false));
    v += __builtin_bit_cast(float, __builtin_amdgcn_update_dpp(0, __builtin_bit_cast(int, v), 0x122, 0xf, 0xf, false));
    v += __builtin_bit_cast(float, __builtin_amdgcn_update_dpp(0, __builtin_bit_cast(int, v), 0x121, 0xf, 0xf, false));
    return v;
}
__device__ __forceinline__ float quad_sum(float v) {
    { const unsigned u = __builtin_bit_cast(unsigned, v); auto r = __builtin_amdgcn_permlane16_swap(u, u, false, false); v = __builtin_bit_cast(float, (unsigned)r[0]) + __builtin_bit_cast(float, (unsigned)r[1]); }
    { const unsigned u = __builtin_bit_cast(unsigned, v); auto r = __builtin_amdgcn_permlane32_swap(u, u, false, false); v = __builtin_bit_cast(float, (unsigned)r[0]) + __builtin_bit_cast(float, (unsigned)r[1]); }
    return v;
}
__device__ __forceinline__ float wave_sum(float v) {
    v = row16_sum(v);
    const int iv = __builtin_bit_cast(int, v);
    return (__builtin_bit_cast(float, __builtin_amdgcn_readlane(iv, 0)) + __builtin_bit_cast(float, __builtin_amdgcn_readlane(iv, 16))) +
           (__builtin_bit_cast(float, __builtin_amdgcn_readlane(iv, 32)) + __builtin_bit_cast(float, __builtin_amdgcn_readlane(iv, 48)));
}
__device__ __forceinline__ float sigmoidf_(float v) { return __builtin_amdgcn_rcpf(1.0f + __builtin_amdgcn_exp2f(-1.4426950408889634f * v)); }
__device__ __forceinline__ void unpack8(u32x4 w, float (&f)[8]) { f[0] = bflo(w.x); f[1] = bfhi(w.x); f[2] = bflo(w.y); f[3] = bfhi(w.y); f[4] = bflo(w.z); f[5] = bfhi(w.z); f[6] = bflo(w.w); f[7] = bfhi(w.w); }
__device__ __forceinline__ u32x4 pack8(const float (&f)[8]) { u32x4 w; w.x = pk2(f[0], f[1]); w.y = pk2(f[2], f[3]); w.z = pk2(f[4], f[5]); w.w = pk2(f[6], f[7]); return w; }
#define LDS_WAIT() asm volatile("s_waitcnt lgkmcnt(0)" ::: "memory")
__device__ __forceinline__ int fresh_tid(int wave_s) { unsigned z = 0u; asm volatile("" : "+v"(z)); int t = wave_s * 64 + (int)__builtin_amdgcn_mbcnt_hi(~0u, __builtin_amdgcn_mbcnt_lo(~0u, z)); asm volatile("" : "+v"(t)); return t; }

namespace pg8 {
constexpr int BM = 256, BK = 64, HALF = 128, HTB = HALF * BK * 2, STAGE_BYTES = 8 * HTB, NXCD = 8, WGM = 4;
__host__ __device__ __forceinline__ int lds_byte(int r, int c) { const int st = (r >> 4) * 2 + (c >> 5), rr = r & 15, cc = c & 31, ob = rr * 64 + cc * 2; return st * 1024 + (ob ^ (((ob >> 9) & 1) << 5)); }
__host__ __device__ __forceinline__ void stage_rc(int b, int& R, int& C) { const int st = b / 1024, sb = b % 1024, swz = sb ^ (((sb >> 9) & 1) << 5); R = (st >> 1) * 16 + swz / 64; C = (st & 1) * 32 + (swz % 64) / 2; }
__host__ __device__ __forceinline__ int perm32(int rho) { const int n = rho >> 4, i = rho & 15; return 8 * (i >> 2) + 4 * n + (i & 3); }
struct Unit { int pm, pn; };
struct Gemm { const bf16_t* A; const bf16_t* Bt; int M, N, K, lda; int ldb = 0; const bf16_t* A2 = nullptr; const bf16_t* Bt2 = nullptr; int khalf = 0; };
struct StaticOrder {
    int nM, nN, nwg, G, c;
    __host__ __device__ void init(int M_, int N_, int G_, int c_) { nM = M_ / BM; nN = N_ / BM; nwg = nM * nN; G = G_; c = c_; }
    __host__ __device__ bool next(int i, Unit& u) const {
        const long L = (long)i * G + c; if (L >= nwg) return false;
        int wgid = (int)L; { const int q = nwg / NXCD, r = nwg % NXCD, xcd = wgid % NXCD, off = wgid / NXCD; wgid = (xcd < r ? xcd * (q + 1) : r * (q + 1) + (xcd - r) * q) + off; }
        const int nig = WGM * nN, gid = wgid / nig, fm = gid * WGM, gsz = (nM - fm) < WGM ? (nM - fm) : WGM;
        u.pm = fm + ((wgid % nig) % gsz); u.pn = (wgid % nig) / gsz; return true;
    }
};
typedef f32x4 Acc[2][2][4][2];

template <class Epi, bool ALIGN_EPI = true, bool SP2 = true>
__device__ __forceinline__ void gemm_phase(int wave_s, LAS unsigned char* lds, const Gemm g, const StaticOrder& S, const Epi& E) {
    const int tid = fresh_tid(wave_s);
    const int wid = __builtin_amdgcn_readfirstlane(tid >> 6), lane = tid & 63, wr = wid >> 2, wc = wid & 3, fr = lane & 15, fq = lane >> 4;
    const int K = g.K, nt = K / BK, LDB = g.ldb ? g.ldb : K, kh = g.khalf ? g.khalf : nt;
    unsigned voffA[2], voffB[2];
#pragma unroll
    for (int i = 0; i < 2; ++i) { int R, C; stage_rc(tid * 16 + i * 8192, R, C); const int Rb = (R & ~31) + perm32(R & 31);
        voffA[i] = (unsigned)(R * g.lda + C) * 2u; voffB[i] = (unsigned)(Rb * LDB + C) * 2u; }
    const size_t kstep = (size_t)(BK * 2);
    const size_t hstepA = (size_t)HALF * g.lda * 2, hstepB = (size_t)HALF * LDB * 2;
    const size_t tstepA = 2 * hstepA, tstepB = 2 * hstepB;
    const unsigned ldsw = (unsigned)wid * 1024u;
    const int aoff = lds_byte(wr * 64 + fr, fq * 8), boff = lds_byte(wc * 32 + fr, fq * 8);
#define PG8_SA(b, h) (((b) * 2 + (h)) * HTB)
#define PG8_SB(b, h) ((4 + (b) * 2 + (h)) * HTB)
#define PG8_STAGE(bufoff, gbase, voff) do { _Pragma("unroll") for (int _i = 0; _i < 2; ++_i) \
        __builtin_amdgcn_global_load_lds((const unsigned*)((const char*)(gbase) + (voff)[_i]), (LAS unsigned*)(lds + (bufoff) + ldsw + _i * 8192), 16, 0, 0); } while (0)
#define PG8_LDA(dst, b, h) do { _Pragma("unroll") for (int m = 0; m < 4; ++m) _Pragma("unroll") for (int k = 0; k < 2; ++k) dst[m][k] = *(const LAS bf16x8*)(lds + PG8_SA(b, h) + aoff + m * 2048 + k * 1024); } while (0)
#define PG8_LDB(dst, b, h) do { _Pragma("unroll") for (int n = 0; n < 2; ++n) _Pragma("unroll") for (int k = 0; k < 2; ++k) dst[n][k] = *(const LAS bf16x8*)(lds + PG8_SB(b, h) + boff + n * 2048 + k * 1024); } while (0)
#define PG8_MMA(ai, bj, At, Bt) do { __builtin_amdgcn_s_setprio(1); _Pragma("unroll") for (int m = 0; m < 4; ++m) _Pragma("unroll") for (int n = 0; n < 2; ++n) _Pragma("unroll") for (int k = 0; k < 2; ++k) \
        acc[ai][bj][m][n] = __builtin_amdgcn_mfma_f32_16x16x32_bf16(Bt[n][k], At[m][k], acc[ai][bj][m][n], 0, 0, 0); __builtin_amdgcn_s_setprio(0); } while (0)
#define PG8_WAIT_V(n) asm volatile("s_waitcnt vmcnt(" #n ")" ::: "memory")
#define PG8_WAIT_L(n) asm volatile("s_waitcnt lgkmcnt(" #n ")" ::: "memory")
#define PG8_BAR __builtin_amdgcn_s_barrier()
#define PG8_SCHED __builtin_amdgcn_sched_barrier(0)
    Unit cur, nxt; int ui = 0;
    if (!S.next(0, cur)) return;
    Acc acc;
#pragma unroll
    for (int a = 0; a < 2; ++a)
#pragma unroll
        for (int b = 0; b < 2; ++b)
#pragma unroll
            for (int m = 0; m < 4; ++m)
#pragma unroll
                for (int n = 0; n < 2; ++n) acc[a][b][m][n] = (f32x4){0.f, 0.f, 0.f, 0.f};
    bf16x8 At[4][2], B0[2][2], B1[2][2];
    const char* cA = (const char*)g.A + (size_t)cur.pm * tstepA; const char* cB = (const char*)g.Bt + (size_t)cur.pn * tstepB;
    const char* sA2 = g.khalf ? (const char*)g.A2 : (const char*)g.A + (size_t)kh * kstep; const char* sB2 = g.khalf ? (const char*)g.Bt2 : (const char*)g.Bt + (size_t)kh * kstep;
    const char* cA2 = sA2 + (size_t)cur.pm * tstepA; const char* cB2 = sB2 + (size_t)cur.pn * tstepB;
#define PG8_TA(tt) ((tt) < kh ? cA + (size_t)(tt) * kstep : cA2 + (size_t)((tt) - kh) * kstep)
#define PG8_TB(tt) ((tt) < kh ? cB + (size_t)(tt) * kstep : cB2 + (size_t)((tt) - kh) * kstep)
    if constexpr (SP2) {
        PG8_STAGE(PG8_SB(0, 0), cB, voffB); PG8_STAGE(PG8_SB(0, 1), cB + hstepB, voffB); PG8_STAGE(PG8_SA(0, 0), cA, voffA); PG8_STAGE(PG8_SA(0, 1), cA + hstepA, voffA);
        if (wr == 1) PG8_BAR;
        PG8_WAIT_V(2); PG8_BAR;
        PG8_STAGE(PG8_SB(1, 0), cB + kstep, voffB); PG8_STAGE(PG8_SA(1, 0), cA + kstep, voffA); PG8_STAGE(PG8_SB(1, 1), cB + hstepB + kstep, voffB);
        PG8_WAIT_V(6); PG8_BAR;
    }
    for (;;) {
        const bool has_next = S.next(ui + 1, nxt);
        const char* nA = has_next ? (const char*)g.A + (size_t)nxt.pm * tstepA : cA; const char* nB = has_next ? (const char*)g.Bt + (size_t)nxt.pn * tstepB : cB;
        for (int t = 0; t < nt; t += 2) {
            const bool last = (t == nt - 2);
            const char* a1 = PG8_TA(t + 1);
            const char* a2 = last ? nA : PG8_TA(t + 2); const char* b2 = last ? nB : PG8_TB(t + 2);
            const char* a3 = last ? nA + kstep : PG8_TA(t + 3); const char* b3 = last ? nB + kstep : PG8_TB(t + 3);
            if constexpr (Epi::HAS_MID) { if (t == kh) E.mid(acc, cur, wr, wc, fr, fq); }
            PG8_LDB(B0, 0, 0); PG8_LDB(B1, 0, 1); PG8_SCHED; PG8_LDA(At, 0, 0); PG8_STAGE(PG8_SA(1, 1), a1 + hstepA, voffA);
            PG8_WAIT_V(8); PG8_WAIT_L(0); PG8_BAR; PG8_MMA(0, 0, At, B0); PG8_MMA(0, 1, At, B1); PG8_BAR; PG8_SCHED;
            PG8_LDA(At, 0, 1); PG8_STAGE(PG8_SB(0, 0), b2, voffB); PG8_STAGE(PG8_SB(0, 1), b2 + hstepB, voffB); PG8_STAGE(PG8_SA(0, 0), a2, voffA);
            PG8_WAIT_V(8); PG8_WAIT_L(0); PG8_BAR; PG8_MMA(1, 0, At, B0); PG8_MMA(1, 1, At, B1); PG8_BAR; PG8_SCHED;
            PG8_LDB(B0, 1, 0); PG8_LDB(B1, 1, 1); PG8_SCHED; PG8_LDA(At, 1, 0); PG8_STAGE(PG8_SA(0, 1), a2 + hstepA, voffA);
            PG8_WAIT_V(8); PG8_WAIT_L(0); PG8_BAR; PG8_MMA(0, 0, At, B0); PG8_MMA(0, 1, At, B1); PG8_BAR; PG8_SCHED;
            PG8_LDA(At, 1, 1); PG8_STAGE(PG8_SB(1, 0), b3, voffB); PG8_STAGE(PG8_SB(1, 1), b3 + hstepB, voffB); PG8_STAGE(PG8_SA(1, 0), a3, voffA);
            PG8_WAIT_V(8); PG8_WAIT_L(0); PG8_BAR; PG8_MMA(1, 0, At, B0); PG8_MMA(1, 1, At, B1); PG8_BAR; PG8_SCHED;
        }
        if constexpr (ALIGN_EPI) { if (wr == 0) PG8_BAR; }
        E(acc, cur, wr, wc, fr, fq);
        if (!has_next) break;
#pragma unroll
        for (int a = 0; a < 2; ++a)
#pragma unroll
            for (int b = 0; b < 2; ++b)
#pragma unroll
                for (int m = 0; m < 4; ++m)
#pragma unroll
                    for (int n = 0; n < 2; ++n) acc[a][b][m][n] = (f32x4){0.f, 0.f, 0.f, 0.f};
        cur = nxt; cA = nA; cB = nB; cA2 = sA2 + (size_t)cur.pm * tstepA; cB2 = sB2 + (size_t)cur.pn * tstepB; ++ui;
        if constexpr (ALIGN_EPI) { if (wr == 1) PG8_BAR; }
    }
    PG8_WAIT_V(0);
    if constexpr (!ALIGN_EPI) { if (wr == 0) PG8_BAR; }
    PG8_BAR;
#undef PG8_SA
#undef PG8_SB
#undef PG8_TA
#undef PG8_TB
#undef PG8_STAGE
#undef PG8_LDA
#undef PG8_LDB
#undef PG8_MMA
#undef PG8_WAIT_V
#undef PG8_WAIT_L
#undef PG8_BAR
#undef PG8_SCHED
}

__device__ __forceinline__ void get8(const Acc& acc, int ai, int bj, int m, float (&v)[8]) {
#pragma unroll
    for (int e = 0; e < 4; ++e) { v[e] = acc[ai][bj][m][0][e]; v[4 + e] = acc[ai][bj][m][1][e]; }
}

struct EpiIn {
    static constexpr bool HAS_MID = false;
    bf16_t* Z; const float* rstd; const float* lbl; const float* qg; const float* kg;
    template <int MODE> __device__ __forceinline__ void run(const Acc& acc, const Unit& u, int wr, int wc, int fr, int fq) const {
        constexpr bool HP = (MODE == 3 || MODE == 4);
        int colb[2];
#pragma unroll
        for (int bj = 0; bj < 2; ++bj) colb[bj] = HP ? (u.pn * 256 + 64 * wc + 32 * bj + 8 * fq) : (u.pn * 256 + 128 * bj + 32 * wc + 8 * fq);
        float aux[2][8];
#pragma unroll
        for (int bj = 0; bj < 2; ++bj)
#pragma unroll
            for (int j = 0; j < 8; ++j) {
                if (MODE == 1) { const int k = colb[bj] - ZC_F + j; const float l0 = lbl[k], l1 = lbl[512 + k]; aux[bj][j] = sigmoidf_(l0 - l1); }
                else if (MODE == 3) aux[bj][j] = qg[(colb[bj] + j) & 63] * C2;
                else if (MODE == 4) aux[bj][j] = kg[(colb[bj] + j) & 63];
                else aux[bj][j] = 0.f;
            }
        float one = 1.0f; asm volatile("" : "+v"(one));
#pragma unroll
        for (int ai = 0; ai < 2; ++ai) {
#pragma unroll
            for (int m = 0; m < 4; ++m) {
                const int row = u.pm * 256 + ai * 128 + wr * 64 + m * 16 + fr;
                float v[2][8];
#pragma unroll
                for (int bj = 0; bj < 2; ++bj) { get8(acc, ai, bj, m, v[bj]);
#pragma unroll
                    for (int j = 0; j < 8; ++j) v[bj][j] *= one; }
                if (HP) {
                    float ss = 0.f;
#pragma unroll
                    for (int bj = 0; bj < 2; ++bj)
#pragma unroll
                        for (int j = 0; j < 8; ++j) ss += v[bj][j] * v[bj][j];
                    ss = quad_sum(ss);
                    const float rn = __builtin_amdgcn_rsqf(ss * (1.0f / 64.0f) + EPS);
#pragma unroll
                    for (int bj = 0; bj < 2; ++bj)
#pragma unroll
                        for (int j = 0; j < 8; ++j) v[bj][j] = v[bj][j] * rn * aux[bj][j];
                }
#pragma unroll
                for (int bj = 0; bj < 2; ++bj) {
#pragma unroll
                    for (int j = 0; j < 8; ++j) {
                        float x = v[bj][j];
                        if (MODE == 0) x = x * sigmoidf_(x);
                        else if (MODE == 1) { const float lb = aux[bj][j]; const float fg = lb + (1.0f - lb) * sigmoidf_(x); x = 0.6931471805599453f * __builtin_amdgcn_logf(fg); }
                        else if (MODE == 5) x = sigmoidf_(x);
                        v[bj][j] = x;
                    }
                    __builtin_nontemporal_store(pack8(v[bj]), (u32x4*)(Z + (size_t)row * ZLD + colb[bj]));
                }
                __builtin_amdgcn_sched_barrier(0);
            }
        }
    }
    __device__ __forceinline__ void operator()(const Acc& acc, const Unit& u, int wr, int wc, int fr, int fq) const {
        const int pn = u.pn;
        if (pn < 2) run<0>(acc, u, wr, wc, fr, fq);
        else if (pn < 4) run<1>(acc, u, wr, wc, fr, fq);
        else if (pn < 6) run<2>(acc, u, wr, wc, fr, fq);
        else if (pn < 8) run<0>(acc, u, wr, wc, fr, fq);
        else if (pn < 10) run<3>(acc, u, wr, wc, fr, fq);
        else if (pn < 12) run<4>(acc, u, wr, wc, fr, fq);
        else if (pn < 14) run<2>(acc, u, wr, wc, fr, fq);
        else run<5>(acc, u, wr, wc, fr, fq);
    }
};

struct EpiGate {
    static constexpr bool HAS_MID = true;
    bf16_t* out; int ldo; const bf16_t* ga; const bf16_t* gb; int ldg;
    __device__ __forceinline__ void mid(Acc& acc, const Unit& u, int wr, int wc, int fr_, int fq) const {
        int fr = fr_; asm volatile("" : "+v"(fr));
#pragma unroll
        for (int ai = 0; ai < 2; ++ai)
#pragma unroll
            for (int m = 0; m < 4; ++m) {
                u32x4 aw[2], bw[2];
#pragma unroll
                for (int bj = 0; bj < 2; ++bj) { const size_t off = (size_t)(u.pm * 256 + ai * 128 + wr * 64 + m * 16 + fr) * ldg + u.pn * 256 + 128 * bj + 32 * wc + 8 * fq;
                    aw[bj] = *(const u32x4*)(ga + off); bw[bj] = *(const u32x4*)(gb + off); }
                if (m & 1) __builtin_amdgcn_sched_barrier(0);
#pragma unroll
                for (int bj = 0; bj < 2; ++bj) { float a8[8], b8[8]; unpack8(aw[bj], a8); unpack8(bw[bj], b8);
#pragma unroll
                    for (int e = 0; e < 4; ++e) { acc[ai][bj][m][0][e] *= b8[e] * __builtin_amdgcn_rcpf(a8[e]); acc[ai][bj][m][1][e] *= b8[4 + e] * __builtin_amdgcn_rcpf(a8[4 + e]); } }
            }
    }
    __device__ __forceinline__ void operator()(const Acc& acc, const Unit& u, int wr, int wc, int fr, int fq) const {
#pragma unroll
        for (int ai = 0; ai < 2; ++ai) {
            u32x4 gw[4][2];
#pragma unroll
            for (int m = 0; m < 4; ++m)
#pragma unroll
                for (int bj = 0; bj < 2; ++bj) gw[m][bj] = *(const u32x4*)(ga + (size_t)(u.pm * 256 + ai * 128 + wr * 64 + m * 16 + fr) * ldg + u.pn * 256 + 128 * bj + 32 * wc + 8 * fq);
            __builtin_amdgcn_sched_barrier(0);
#pragma unroll
            for (int m = 0; m < 4; ++m)
#pragma unroll
                for (int bj = 0; bj < 2; ++bj) { const int row = u.pm * 256 + ai * 128 + wr * 64 + m * 16 + fr, col = u.pn * 256 + 128 * bj + 32 * wc + 8 * fq;
                    float v[8], gt[8]; get8(acc, ai, bj, m, v); unpack8(gw[m][bj], gt);
#pragma unroll
                    for (int j = 0; j < 8; ++j) v[j] = gt[j] * v[j];
                    *(u32x4*)(out + (size_t)row * ldo + col) = pack8(v); }
            __builtin_amdgcn_sched_barrier(0);
        }
    }
};

template <bool BF16IN> struct EpiResid {
    static constexpr bool HAS_MID = false;
    const float* xin; const bf16_t* xinb; bf16_t* xb; float* ssq;
    __device__ __forceinline__ void operator()(const Acc& acc, const Unit& u, int wr, int wc, int fr, int fq) const {
#pragma unroll
        for (int ai = 0; ai < 2; ++ai)
#pragma unroll
            for (int mh = 0; mh < 2; ++mh) {
                f32x4 x0[2][2], x1[2][2]; u32x4 xw[2][2];
#pragma unroll
                for (int m2 = 0; m2 < 2; ++m2)
#pragma unroll
                    for (int bj = 0; bj < 2; ++bj) { const size_t off = (size_t)(u.pm * 256 + ai * 128 + wr * 64 + (2 * mh + m2) * 16 + fr) * DMODEL + u.pn * 256 + 128 * bj + 32 * wc + 8 * fq;
                        if constexpr (BF16IN) xw[m2][bj] = *(const u32x4*)(xinb + off); else { x0[m2][bj] = *(const f32x4*)(xin + off); x1[m2][bj] = *(const f32x4*)(xin + off + 4); } }
                __builtin_amdgcn_sched_barrier(0);
#pragma unroll
                for (int m2 = 0; m2 < 2; ++m2) {
                    const int m = 2 * mh + m2;
                    const int row = u.pm * 256 + ai * 128 + wr * 64 + m * 16 + fr;
                    float ss = 0.f;
#pragma unroll
                    for (int bj = 0; bj < 2; ++bj) {
                        const size_t off = (size_t)row * DMODEL + u.pn * 256 + 128 * bj + 32 * wc + 8 * fq;
                        float v[8], xr[8]; get8(acc, ai, bj, m, v);
                        if constexpr (BF16IN) unpack8(xw[m2][bj], xr);
                        else {
#pragma unroll
                            for (int j = 0; j < 4; ++j) { xr[j] = x0[m2][bj][j]; xr[4 + j] = x1[m2][bj][j]; } }
#pragma unroll
                        for (int j = 0; j < 8; ++j) { v[j] += xr[j]; ss += v[j] * v[j]; }
                        *(u32x4*)(xb + off) = pack8(v);
                    }
                    ss = quad_sum(ss);
                    if (fq == 0) ssq[(size_t)row * 16 + u.pn * 4 + wc] = ss;
                }
                __builtin_amdgcn_sched_barrier(0);
            }
    }
};
__device__ __forceinline__ void rstd8_from_ssq(const float* ssq, const Unit& u, int wr, int fr, int fq, float (&rs)[2][4]) {
    f32x4 sq[2][4];
#pragma unroll
    for (int ai = 0; ai < 2; ++ai)
#pragma unroll
        for (int m = 0; m < 4; ++m) sq[ai][m] = *(const f32x4*)(ssq + (size_t)(u.pm * 256 + ai * 128 + wr * 64 + m * 16 + fr) * 16 + 4 * fq);
    __builtin_amdgcn_sched_barrier(0);
    float p[2][4];
#pragma unroll
    for (int ai = 0; ai < 2; ++ai)
#pragma unroll
        for (int m = 0; m < 4; ++m) p[ai][m] = (sq[ai][m][0] + sq[ai][m][1]) + (sq[ai][m][2] + sq[ai][m][3]);
#pragma unroll
    for (int ai = 0; ai < 2; ++ai)
#pragma unroll
        for (int m = 0; m < 4; ++m) p[ai][m] = quad_sum(p[ai][m]);
#pragma unroll
    for (int ai = 0; ai < 2; ++ai)
#pragma unroll
        for (int m = 0; m < 4; ++m) rs[ai][m] = __builtin_amdgcn_rsqf(p[ai][m] * (1.0f / DMODEL) + EPS);
}
__device__ __forceinline__ float rstd_from_ssq(const float* ssq, int row) {
    const f32x4* p = (const f32x4*)(ssq + (size_t)row * 16);
    const f32x4 a = p[0], b = p[1], c = p[2], d = p[3];
    const float s = ((a[0] + a[1]) + (a[2] + a[3])) + ((b[0] + b[1]) + (b[2] + b[3])) + ((c[0] + c[1]) + (c[2] + c[3])) + ((d[0] + d[1]) + (d[2] + d[3]));
    return 1.0f / sqrtf(s * (1.0f / DMODEL) + EPS);
}
struct EpiSwiglu {
    static constexpr bool HAS_MID = false;
    bf16_t* H; const float* ssq;
    __device__ __forceinline__ void operator()(const Acc& acc, const Unit& u, int wr, int wc, int fr, int fq) const {
        float rsv[2][4]; rstd8_from_ssq(ssq, u, wr, fr, fq, rsv);
#pragma unroll
        for (int ai = 0; ai < 2; ++ai)
#pragma unroll
            for (int m = 0; m < 4; ++m) {
                const int row = u.pm * 256 + ai * 128 + wr * 64 + m * 16 + fr;
                const float rs = rsv[ai][m];
                float gv[8], uv[8]; get8(acc, ai, 0, m, gv); get8(acc, ai, 1, m, uv);
#pragma unroll
                for (int j = 0; j < 8; ++j) { const float gg = gv[j] * rs; gv[j] = gg * sigmoidf_(gg) * (uv[j] * rs); }
                *(u32x4*)(H + (size_t)row * DFF + u.pn * 128 + 32 * wc + 8 * fq) = pack8(gv);
            }
    }
};
struct EpiPlain {
    static constexpr bool HAS_MID = false;
    bf16_t* out; int ldo;
    __device__ __forceinline__ void operator()(const Acc& acc, const Unit& u, int wr, int wc, int fr, int fq) const {
#pragma unroll
        for (int ai = 0; ai < 2; ++ai)
#pragma unroll
            for (int m = 0; m < 4; ++m) {
                const int row = u.pm * 256 + ai * 128 + wr * 64 + m * 16 + fr;
#pragma unroll
                for (int bj = 0; bj < 2; ++bj) { float v[8]; get8(acc, ai, bj, m, v); *(u32x4*)(out + (size_t)row * ldo + u.pn * 256 + 128 * bj + 32 * wc + 8 * fq) = pack8(v); }
            }
    }
};
struct EpiPle {
    static constexpr bool HAS_MID = false;
    float* out; const bf16_t* x2b; const bf16_t* pp; const float* ssq;
    __device__ __forceinline__ void operator()(const Acc& acc, const Unit& u, int wr, int wc, int fr, int fq) const {
        float rsv[2][4]; rstd8_from_ssq(ssq, u, wr, fr, fq, rsv);
#pragma unroll
        for (int ai = 0; ai < 2; ++ai) {
            u32x4 xw[4][2], pw[4][2];
#pragma unroll
            for (int m = 0; m < 4; ++m)
#pragma unroll
                for (int bj = 0; bj < 2; ++bj) { const size_t off = (size_t)(u.pm * 256 + ai * 128 + wr * 64 + m * 16 + fr) * DMODEL + u.pn * 256 + 128 * bj + 32 * wc + 8 * fq;
                    xw[m][bj] = *(const u32x4*)(x2b + off); pw[m][bj] = *(const u32x4*)(pp + off); }
            __builtin_amdgcn_sched_barrier(0);
#pragma unroll
            for (int m = 0; m < 4; ++m) {
                const float rs = rsv[ai][m];
#pragma unroll
                for (int bj = 0; bj < 2; ++bj) {
                    const size_t off = (size_t)(u.pm * 256 + ai * 128 + wr * 64 + m * 16 + fr) * DMODEL + u.pn * 256 + 128 * bj + 32 * wc + 8 * fq;
                    float v[8], pv[8], xr[8]; get8(acc, ai, bj, m, v); unpack8(pw[m][bj], pv); unpack8(xw[m][bj], xr);
#pragma unroll
                    for (int j = 0; j < 8; ++j) v[j] = xr[j] + sigmoidf_(v[j] * rs) * pv[j];
                    *(f32x4*)(out + off) = (f32x4){v[0], v[1], v[2], v[3]}; *(f32x4*)(out + off + 4) = (f32x4){v[4], v[5], v[6], v[7]};
                }
            }
            __builtin_amdgcn_sched_barrier(0);
        }
    }
};
}

#include <hip/hip_bf16.h>
#include <cmath>
namespace attn_body {
using bf16=__hip_bfloat16;
using bf16x8=__attribute__((ext_vector_type(8)))short;
using s16x4=__attribute__((ext_vector_type(4)))short;
using f32x16=__attribute__((ext_vector_type(16)))float;
using u32x4=__attribute__((ext_vector_type(4)))unsigned;
constexpr int BATCH=8,NHEAD=8,SEQ=4096,D=64,DM=5632;
constexpr int NW=8,QBLK=32,QB=QBLK*NW,KVBLK=64,NQB=SEQ/QB;
constexpr int ATTN_PITCH=DM, ATTN_UNIT_ROWS=QB;
__device__ __forceinline__ int crow(int r,int hi){return (r&3)+8*(r>>2)+4*hi;}
#define SBAR() __builtin_amdgcn_sched_barrier(0)
__device__ __forceinline__ void cmask(f32x16&p0,f32x16&p1,int jb,int qrel,int hi){
  const float NEG=-INFINITY; int kb=64*jb+4*hi;
  #pragma unroll
  for(int r=0;r<16;++r){int kv=kb+(r&3)+8*(r>>2); if(kv>qrel)p0[r]=NEG; if(kv+32>qrel)p1[r]=NEG;}
}

constexpr int NSLOT=3, SLOTB=8192;
constexpr int LDS_K=0, LDS_V=NSLOT*SLOTB, LDS_WS=2*NSLOT*SLOTB, LDS_OST=LDS_WS+NW*64*4, LDS_BYTES=LDS_OST+NW*4096, LDS_CB=LDS_BYTES, LDS_CQ=LDS_CB+32768, LDS_TOTAL=LDS_CQ+NW*128;
constexpr float C2=0.125f*1.4426950408889634f;
__device__ __forceinline__ void glds16(const void*gsrc,unsigned lds_dst){unsigned keep;
  asm volatile("s_mov_b32 %0, m0\n\ts_mov_b32 m0, %2\n\ts_nop 0\n\tglobal_load_lds_dwordx4 %1, off\n\ts_mov_b32 m0, %0":"=&s"(keep):"v"(gsrc),"s"(lds_dst):"memory");}
__device__ __forceinline__ float max3f(float a,float b,float c){float r;asm("v_max3_f32 %0, %1, %2, %3":"=v"(r):"v"(a),"v"(b),"v"(c));return r;}
__device__ __forceinline__ float max2f(float a,float b){float r;asm("v_max_f32_e32 %0, %1, %2":"=v"(r):"v"(a),"v"(b));return r;}
__device__ __forceinline__ float fadd_s(float a,float b){float r;asm("v_add_f32_e32 %0, %1, %2":"=v"(r):"v"(a),"v"(b));return r;}
__device__ __forceinline__ float fsub_s(float a,float b){float r;asm("v_sub_f32_e32 %0, %1, %2":"=v"(r):"v"(a),"v"(b));return r;}
typedef float f32x2_t __attribute__((ext_vector_type(2))); typedef unsigned u32x2v __attribute__((ext_vector_type(2))); typedef __bf16 bf16x2_t __attribute__((ext_vector_type(2)));
__device__ __forceinline__ unsigned cvtpk_s(float lo,float hi){f32x2_t v={lo,hi};bf16x2_t b=__builtin_convertvector(v,bf16x2_t);return __builtin_bit_cast(unsigned,b);}
#define WAIT_BAR(N) asm volatile("s_waitcnt vmcnt(" #N ") lgkmcnt(0)\n\ts_barrier":::"memory")

__device__ __forceinline__ void qkt(f32x16&p0,f32x16&p1,const char*Kslot,const bf16x8*qr,int r32,int hi,bf16x8 kb0,bf16x8 kb1,bf16x8 qone){
  const char*kb=Kslot+hi*1024+r32*16;
  #pragma unroll
  for(int d0=0;d0<4;++d0){
    const bf16x8 b0=*reinterpret_cast<const bf16x8*>(kb+d0*2048);
    const bf16x8 b1=*reinterpret_cast<const bf16x8*>(kb+d0*2048+512);
    if(d0==0){p0=__builtin_amdgcn_mfma_f32_32x32x16_bf16(kb0,qone,f32x16{},0,0,0);p1=__builtin_amdgcn_mfma_f32_32x32x16_bf16(kb1,qone,f32x16{},0,0,0);}
    p0=__builtin_amdgcn_mfma_f32_32x32x16_bf16(b0,qr[d0],p0,0,0,0);p1=__builtin_amdgcn_mfma_f32_32x32x16_bf16(b1,qr[d0],p1,0,0,0);}
}
typedef __attribute__((address_space(3))) const char* lds_cptr;
typedef short v4i16_t __attribute__((ext_vector_type(4)));
__device__ __forceinline__ void kload8(bf16x8*kf,lds_cptr kp){
  kf[0]=*(const __attribute__((address_space(3))) bf16x8*)(kp);      kf[1]=*(const __attribute__((address_space(3))) bf16x8*)(kp+512);
  kf[2]=*(const __attribute__((address_space(3))) bf16x8*)(kp+2048); kf[3]=*(const __attribute__((address_space(3))) bf16x8*)(kp+2560);
  kf[4]=*(const __attribute__((address_space(3))) bf16x8*)(kp+4096); kf[5]=*(const __attribute__((address_space(3))) bf16x8*)(kp+4608);
  kf[6]=*(const __attribute__((address_space(3))) bf16x8*)(kp+6144); kf[7]=*(const __attribute__((address_space(3))) bf16x8*)(kp+6656);
}
__device__ __forceinline__ void kload2(bf16x8*kf,lds_cptr kp,int j){ kf[2*j]=*(const __attribute__((address_space(3))) bf16x8*)(kp+j*2048); kf[2*j+1]=*(const __attribute__((address_space(3))) bf16x8*)(kp+j*2048+512); }
__device__ __forceinline__ s16x4 vtr(lds_cptr p){ return __builtin_bit_cast(s16x4,__builtin_amdgcn_ds_read_tr16_b64_v4i16((__attribute__((address_space(3))) v4i16_t*)p)); }
__device__ __forceinline__ float rowmax(const f32x16&p0,const f32x16&p1){
  float a=max3f(p0[0],p0[1],p1[0]),b=max3f(p0[2],p0[3],p1[1]);a=max3f(a,p1[2],p1[3]);
  #pragma unroll
  for(int r=4;r<16;r+=4){a=max3f(a,p0[r],p0[r+1]);b=max3f(b,p0[r+2],p0[r+3]);a=max3f(a,p1[r],p1[r+1]);b=max3f(b,p1[r+2],p1[r+3]);}
  const float m=max2f(a,b);
  auto rr=__builtin_amdgcn_permlane32_swap(__float_as_uint(m),__float_as_uint(m),false,false);
  return max2f(__uint_as_float(rr[0]),__uint_as_float(rr[1]));
}
__device__ __forceinline__ void pv(f32x16*o,int vb,bf16x8 pa0,bf16x8 pa1,bf16x8 pa2,bf16x8 pa3){
  #pragma unroll
  for(int d0=0;d0<2;++d0){s16x4 lo[4],hi[4];
    #pragma unroll
    for(int ks=0;ks<4;++ks){
      asm volatile("ds_read_b64_tr_b16 %0,%1 offset:%c2":"=&v"(lo[ks]):"v"(vb),"i"(d0*4096+ks*1024):"memory");
      asm volatile("ds_read_b64_tr_b16 %0,%1 offset:%c2":"=&v"(hi[ks]):"v"(vb),"i"(d0*4096+ks*1024+512):"memory");}
    asm volatile("s_waitcnt lgkmcnt(0)":::"memory");SBAR();
    #define PK(k) (bf16x8){lo[k][0],lo[k][1],lo[k][2],lo[k][3],hi[k][0],hi[k][1],hi[k][2],hi[k][3]}
    o[d0]=__builtin_amdgcn_mfma_f32_32x32x16_bf16(pa0,PK(0),o[d0],0,0,0);
    o[d0]=__builtin_amdgcn_mfma_f32_32x32x16_bf16(pa1,PK(1),o[d0],0,0,0);
    o[d0]=__builtin_amdgcn_mfma_f32_32x32x16_bf16(pa2,PK(2),o[d0],0,0,0);
    o[d0]=__builtin_amdgcn_mfma_f32_32x32x16_bf16(pa3,PK(3),o[d0],0,0,0);
    #undef PK
  }
}

#ifndef ATTN_STORE16
#define ATTN_STORE16(p,v) (*(u32x4*)(p)=(v))
#endif
template<int THRL> __device__ __forceinline__ void attn_unit(int wave_s,bool dostore,int b,int h,int qb,int t0,const double*cdh,const bf16*Q,const bf16*__restrict__ K,const bf16*__restrict__ V,bf16*O,char*shm){
  const int tid=fresh_tid(wave_s); const int lane=tid&63,r32=lane&31,hi=lane>>5; const int wid=__builtin_amdgcn_readfirstlane(tid>>6);
  const long rowbase=(long)b*SEQ; const int q0=qb*QB;
  const bf16*Qw=Q+(rowbase+q0+wid*QBLK)*DM+h*D;
  const bf16*Kh=K+(rowbase+t0*KVBLK)*DM+h*D,*Vh=V+(rowbase+t0*KVBLK)*DM+h*D;
  const unsigned lds0=(unsigned)(uintptr_t)shm;
  float*wsf=(float*)(shm+LDS_WS)+wid*64;
  const bf16*ksrc=Kh+(long)lane*DM+wid*8;
  const bf16*vsrc=Vh+(long)(16*(wid&3)+(lane>>2))*DM+(wid>>2)*32+(lane&3)*8;
  const unsigned kdst=lds0+LDS_K+wid*1024, vdst=lds0+LDS_V+wid*1024;
  #define DMA_K(t,slot) glds16(ksrc+(long)(t)*KVBLK*DM,(unsigned)__builtin_amdgcn_readfirstlane(kdst+(slot)))
  #define DMA_V(t,slot) glds16(vsrc+(long)(t)*KVBLK*DM,(unsigned)__builtin_amdgcn_readfirstlane(vdst+(slot)))
  const char*Kbase=shm+LDS_K; bf16x8 kf[8];
  const lds_cptr shm3=(lds_cptr)shm; const lds_cptr kp0=shm3+LDS_K+hi*1024+r32*16; const lds_cptr vp0=shm3+LDS_V+((lane>>4)&1)*32+(lane&3)*8+(4*hi+((lane&15)>>2))*64;
  const int NT=(q0+QB)/KVBLK-t0;
  const lds_cptr cbp=shm3+LDS_CB+r32*8; float cq; float*cqs=(float*)(shm+LDS_CQ)+wid*32+r32;
  DMA_K(0,0);DMA_V(0,0);DMA_K(1,SLOTB);
  { const double c0=cdh[q0]; const int nk=q0+QB-t0*KVBLK; const double*cs=cdh+t0*KVBLK;
    double cv[8]; const double cqd=cdh[q0+wid*QBLK+r32];
    #pragma unroll
    for(int j=0;j<8;++j){ const int i=tid+j*NW*64; cv[j]=cs[i<nk?i:nk-1]; }
    #pragma unroll
    for(int j=0;j<8;++j){ const int i=tid+j*NW*64; if(i<nk){ const float kbv=(float)((c0-cv[j])*1.4426950408889634);
      const unsigned uh=__float_as_uint(kbv)&0xffff0000u; const float r1=kbv-__uint_as_float(uh);
      const unsigned um=__float_as_uint(r1)&0xffff0000u; const float r2=r1-__uint_as_float(um);
      const unsigned ul=__float_as_uint(r2)&0xffff0000u;
      *(__attribute__((address_space(3))) u32x2v*)((__attribute__((address_space(3))) char*)(shm3+LDS_CB)+i*8)=(u32x2v){(uh>>16)|um,(ul>>16)|0x3F800000u}; } }
    cq=(float)((cqd-c0)*1.4426950408889634); if(hi==0)*cqs=cq; }
  u32x4 qb4=(u32x4){hi?0u:0x3F803F80u,0u,0u,0u};
  #define SETNEG(val) do{ const float nv_=(val); const unsigned nh_=__float_as_uint(nv_)&0xffff0000u; const float n1_=nv_-__uint_as_float(nh_); \
    const unsigned nm_=__float_as_uint(n1_)&0xffff0000u; const float n2_=n1_-__uint_as_float(nm_); const unsigned nl_=__float_as_uint(n2_)&0xffff0000u; \
    qb4[1]=hi?0u:(0x3F80u|nh_); qb4[2]=hi?0u:((nm_>>16)|nl_); }while(0)
  #define qone __builtin_bit_cast(bf16x8,qb4)
  u32x2v kbn0,kbn1;
  #define KBLD(t) do{ kbn0=*(const __attribute__((address_space(3))) u32x2v*)(cbp+(t)*512); kbn1=*(const __attribute__((address_space(3))) u32x2v*)(cbp+(t)*512+256); }while(0)
  #define KBF(x) __builtin_bit_cast(bf16x8,(u32x4){x[0],x[1],0x3F803F80u,0u})
  bf16x8 qr[4];
  #pragma unroll
  for(int d0=0;d0<4;++d0)qr[d0]=*reinterpret_cast<const bf16x8*>(&Qw[(long)r32*DM+d0*16+hi*8]);
  float mhat=0.f,l_reg=0.f;f32x16 o[2];o[0]=f32x16{};o[1]=f32x16{};SETNEG(cq);
  const int qrel=wid*QBLK+r32;
  #define CMASK(P0,P1,t) do{int jb_=(t)-(NT-4); if(jb_>=0)cmask(P0,P1,jb_,qrel,hi);}while(0)
  bool resc=false;
  #define START(P0,P1) do{ const float rm=rowmax(P0,P1); resc=false; \
    { const float dl=rm; mhat=fadd_s(mhat,dl); \
      _Pragma("unroll") for(int r=0;r<16;++r){P0[r]=fsub_s(P0[r],dl);P1[r]=fsub_s(P1[r],dl);} \
      SETNEG(*cqs-mhat); } \
    _Pragma("unroll") for(int r=0;r<16;++r)P0[r]=__builtin_amdgcn_exp2f(P0[r]); }while(0)
  #define RESC() do{ if(resc){ asm volatile("s_waitcnt lgkmcnt(0)":::"memory"); \
      _Pragma("unroll") for(int d_=0;d_<2;++d_) _Pragma("unroll") for(int r=0;r<16;++r)o[d_][r]*=wsf[crow(r,hi)]; } }while(0)
  f32x16 pA0,pA1,pB0,pB1;
  int sl_prev=0,sl_cur=0,sl_next=SLOTB;
  #define ROT() do{sl_prev=sl_cur;sl_cur=sl_next;sl_next=(sl_next==(NSLOT-1)*SLOTB)?0:sl_next+SLOTB;}while(0)
  DMA_K(2,2*SLOTB);
  WAIT_BAR(3);
  KBLD(0);
  qkt(pA0,pA1,Kbase,qr,r32,hi,KBF(kbn0),KBF(kbn1),qone); KBLD(1);asm volatile("s_nop 15\n\ts_nop 7":"+v"(pA0),"+v"(pA1));CMASK(pA0,pA1,0);
  START(pA0,pA1);
  _Pragma("unroll") for(int r=0;r<16;++r)pA1[r]=__builtin_amdgcn_exp2f(pA1[r]);
  WAIT_BAR(0);
  DMA_K(3,0);DMA_V(1,SLOTB);
  ROT();
  kload8(kf,kp0+sl_cur);
  WAIT_BAR(2);
  s16x4 vlo[8],vhi[8]; u32x4 pw0,pw1,pw2,pw3;
  #define PKW(P,B) cvtpk_s(P[B],P[B+1])
  #define PAF(k) __builtin_bit_cast(bf16x8,pw##k)
  #define VFR(i) (bf16x8){vlo[i][0],vlo[i][1],vlo[i][2],vlo[i][3],vhi[i][0],vhi[i][1],vhi[i][2],vhi[i][3]}
  #define PIN(x) asm volatile("":"+v"(x))
  #define MX3(a,b,c) __builtin_fmaxf(__builtin_fmaxf((a),(b)),(c))
  #define GAPA(MF,A0,A1,A2,A3,W0,W1,PW) do{ MF; sacc+=A0; sacc+=A1; sacc+=A2; sacc+=A3; PIN(sacc); W0; W1; PIN(PW); SBAR(); }while(0)
  #define EX(v) __builtin_amdgcn_exp2f(v)
  #define GAPB(MF,X,B) do{ MF; X[B]=EX(X[B]); X[B+1]=EX(X[B+1]); X[B+2]=EX(X[B+2]); X[B+3]=EX(X[B+3]); PIN(X); SBAR(); }while(0)
  #define VRD(i) do{ vlo[i]=vtr(vp_+(((i)>>2)*4096+((i)&3)*1024)); vhi[i]=vtr(vp_+(((i)>>2)*4096+((i)&3)*1024+512)); }while(0)
  #define KRD(G,j) do{ if(G){ kload2(kf,kp0+sl_next,j); SBAR(); } }while(0)
  #define STEP(C0,C1,P0,P1,t,GK,GV,GL) do{ SBAR(); \
    const lds_cptr vp_=vp0+sl_prev; \
    C0=__builtin_amdgcn_mfma_f32_32x32x16_bf16(KBF(kbn0),qone,f32x16{},0,0,0); C1=__builtin_amdgcn_mfma_f32_32x32x16_bf16(KBF(kbn1),qone,f32x16{},0,0,0); SBAR(); \
    VRD(0); SBAR(); float sacc=(P0[0]+P0[1]); \
    GAPA(C0=__builtin_amdgcn_mfma_f32_32x32x16_bf16(kf[0],qr[0],C0,0,0,0), P0[2],P0[3],P0[4],P0[5],     pw0[0]=PKW(P0,0), pw0[1]=PKW(P0,2), pw0); \
    VRD(4); SBAR(); GAPA(C1=__builtin_amdgcn_mfma_f32_32x32x16_bf16(kf[1],qr[0],C1,0,0,0), P0[6],P0[7],P0[8],P0[9],     pw0[2]=PKW(P0,4), pw0[3]=PKW(P0,6), pw0); \
    VRD(1); SBAR(); GAPA(C0=__builtin_amdgcn_mfma_f32_32x32x16_bf16(kf[2],qr[1],C0,0,0,0),   P0[10],P0[11],P0[12],P0[13], pw1[0]=PKW(P0,8), pw1[1]=PKW(P0,10), pw1); \
    VRD(5); SBAR(); GAPA(C1=__builtin_amdgcn_mfma_f32_32x32x16_bf16(kf[3],qr[1],C1,0,0,0),   P0[14],P0[15],P1[0],P1[1],   pw1[2]=PKW(P0,12),pw1[3]=PKW(P0,14), pw1); \
    VRD(2); SBAR(); GAPA(C0=__builtin_amdgcn_mfma_f32_32x32x16_bf16(kf[4],qr[2],C0,0,0,0),   P1[2],P1[3],P1[4],P1[5],     pw2[0]=PKW(P1,0), pw2[1]=PKW(P1,2), pw2); \
    VRD(6); SBAR(); GAPA(C1=__builtin_amdgcn_mfma_f32_32x32x16_bf16(kf[5],qr[2],C1,0,0,0),   P1[6],P1[7],P1[8],P1[9],     pw2[2]=PKW(P1,4), pw2[3]=PKW(P1,6), pw2); \
    VRD(3); SBAR(); GAPA(C0=__builtin_amdgcn_mfma_f32_32x32x16_bf16(kf[6],qr[3],C0,0,0,0),   P1[10],P1[11],P1[12],P1[13], pw3[0]=PKW(P1,8), pw3[1]=PKW(P1,10), pw3); \
    VRD(7); SBAR(); GAPA(C1=__builtin_amdgcn_mfma_f32_32x32x16_bf16(kf[7],qr[3],C1,0,0,0),   P1[14],P1[15],0.f,0.f,       pw3[2]=PKW(P1,12),pw3[3]=PKW(P1,14), pw3); \
    l_reg+=sacc; \
    if(GK){DMA_K((t)+3,sl_cur);} if(GV){DMA_V((t)+1,sl_next);} \
    CMASK(C0,C1,t); \
    { float a=MX3(C0[0],C0[1],C1[0]),b=MX3(C0[2],C0[3],C1[1]); a=MX3(a,C1[2],C1[3]); \
      _Pragma("unroll") for(int r=4;r<16;r+=4){a=MX3(a,C0[r],C0[r+1]);b=MX3(b,C0[r+2],C0[r+3]);a=MX3(a,C1[r],C1[r+1]);b=MX3(b,C1[r+2],C1[r+3]);} \
      float rm=__builtin_fmaxf(a,b); { auto rr=__builtin_amdgcn_permlane32_swap(__float_as_uint(rm),__float_as_uint(rm),false,false); rm=__builtin_fmaxf(__uint_as_float(rr[0]),__uint_as_float(rr[1])); } \
      resc=false; \
      if(__builtin_expect(__any(rm>(float)THRL),0)){ const float dl=__builtin_fmaxf(rm,0.f); mhat+=dl; \
        _Pragma("unroll") for(int r=0;r<16;++r){C0[r]-=dl;C1[r]-=dl;} \
        SETNEG(*cqs-mhat); \
        const float f=__builtin_amdgcn_exp2f(-dl); l_reg*=f; if(hi==0)wsf[r32]=f; resc=true; } } \
    SBAR(); \
    GAPB(o[0]=__builtin_amdgcn_mfma_f32_32x32x16_bf16(PAF(0),VFR(0),o[0],0,0,0), C0,0); \
    GAPB(o[1]=__builtin_amdgcn_mfma_f32_32x32x16_bf16(PAF(0),VFR(4),o[1],0,0,0), C0,4); \
    if(GL){KBLD((t)+1);} KRD(GL,0); GAPB(o[0]=__builtin_amdgcn_mfma_f32_32x32x16_bf16(PAF(1),VFR(1),o[0],0,0,0), C0,8); \
    KRD(GL,1); GAPB(o[1]=__builtin_amdgcn_mfma_f32_32x32x16_bf16(PAF(1),VFR(5),o[1],0,0,0), C0,12); \
    KRD(GL,2); GAPB(o[0]=__builtin_amdgcn_mfma_f32_32x32x16_bf16(PAF(2),VFR(2),o[0],0,0,0), C1,0); \
    KRD(GL,3); GAPB(o[1]=__builtin_amdgcn_mfma_f32_32x32x16_bf16(PAF(2),VFR(6),o[1],0,0,0), C1,4); \
    GAPB(o[0]=__builtin_amdgcn_mfma_f32_32x32x16_bf16(PAF(3),VFR(3),o[0],0,0,0), C1,8); \
    GAPB(o[1]=__builtin_amdgcn_mfma_f32_32x32x16_bf16(PAF(3),VFR(7),o[1],0,0,0), C1,12); \
    }while(0)
  int t=1;
  #undef CMASK
  #define CMASK(P0,P1,t) do{}while(0)
  for(;t+5<NT;t+=2){
    STEP(pB0,pB1,pA0,pA1,t,true,true,true);     WAIT_BAR(2); RESC(); ROT();
    STEP(pA0,pA1,pB0,pB1,t+1,true,true,true);   WAIT_BAR(2); RESC(); ROT();
  }
  #undef CMASK
  #define CMASK(P0,P1,t) do{int jb_=(t)-(NT-4); if(jb_>=0)cmask(P0,P1,jb_,qrel,hi);}while(0)
  #define ENDW(tt) do{ if((tt)+3<NT){WAIT_BAR(2);} else if((tt)+2<NT){WAIT_BAR(1);} else {WAIT_BAR(0);} }while(0)
  for(;t+1<NT;t+=2){
    STEP(pB0,pB1,pA0,pA1,t,(t+3<NT),(t+1<NT),(t+1<NT));       ENDW(t);   RESC(); ROT();
    STEP(pA0,pA1,pB0,pB1,t+1,(t+4<NT),(t+2<NT),(t+2<NT));     ENDW(t+1); RESC(); ROT();
  }
  STEP(pB0,pB1,pA0,pA1,NT-1,false,false,false); RESC();
  { float sacc=pB0[0]+pB0[1]; _Pragma("unroll") for(int r=2;r<16;++r)sacc+=pB0[r]; _Pragma("unroll") for(int r=0;r<16;++r)sacc+=pB1[r]; l_reg+=sacc;
    pw0=(u32x4){PKW(pB0,0),PKW(pB0,2),PKW(pB0,4),PKW(pB0,6)};pw1=(u32x4){PKW(pB0,8),PKW(pB0,10),PKW(pB0,12),PKW(pB0,14)};pw2=(u32x4){PKW(pB1,0),PKW(pB1,2),PKW(pB1,4),PKW(pB1,6)};pw3=(u32x4){PKW(pB1,8),PKW(pB1,10),PKW(pB1,12),PKW(pB1,14)};
    const int vb0=(int)(lds0+LDS_V)+((lane>>4)&1)*32+(lane&3)*8+(4*hi+((lane&15)>>2))*64;
    SBAR(); pv(o,vb0+sl_cur,PAF(0),PAF(1),PAF(2),PAF(3)); }
  #undef PKW
  #undef PAF
  #undef VFR
  #undef PIN
  #undef MX3
  #undef GAPA
  #undef GAPB
  #undef EX
  #undef VRD
  #undef KRD
  #undef STEP
  #undef ENDW
  {auto rr=__builtin_amdgcn_permlane32_swap(__float_as_uint(l_reg),__float_as_uint(l_reg),false,false);l_reg=__uint_as_float(rr[0])+__uint_as_float(rr[1]);}
  if(hi==0)wsf[32+r32]=l_reg;asm volatile("s_waitcnt lgkmcnt(0)":::"memory");
  float rli[16];
  #pragma unroll
  for(int r=0;r<16;++r)rli[r]=__builtin_amdgcn_rcpf(wsf[32+crow(r,hi)]);
  bf16*Ow=O+(rowbase+q0+wid*QBLK)*DM+h*D;
  { bf16*stg=(bf16*)(shm+LDS_OST)+wid*2048;
    #pragma unroll
    for(int r=0;r<16;++r){const int orow=crow(r,hi);
      #pragma unroll
      for(int d0=0;d0<2;++d0)stg[orow*64+d0*32+r32]=__float2bfloat16(o[d0][r]*rli[r]);}
    asm volatile("s_waitcnt lgkmcnt(0)":::"memory");
    #pragma unroll
    for(int i=0;i<4;++i){const int row=i*8+(lane>>3),ch=lane&7; const u32x4 v=*(const u32x4*)(stg+row*64+ch*8); if(dostore)ATTN_STORE16(Ow+(long)row*DM+ch*8,v);} }
  asm volatile("s_waitcnt lgkmcnt(0)\n\ts_barrier":::"memory");
  #undef DMA_K
  #undef KBLD
  #undef KBF
  #undef SETNEG
  #undef qone
  #undef DMA_V
  #undef CMASK
  #undef START
  #undef RESC
  #undef ROT
}
constexpr int ATTN_LDS_BYTES=LDS_TOTAL;
#undef SBAR
#undef WAIT_BAR
}

struct Args { const float* in[19]; float* out; unsigned char* ws; int ph; int pad; };
struct Frame {
    LAS unsigned char* lds;
    int tid, lane, wave, G, wave0;
    const float* in[19]; float* out; unsigned char* ws;
};
enum { I_X = 0, I_P, I_GMIX, I_WIN, I_LBL, I_ONG, I_FBIAS, I_QG, I_KG, I_WA, I_WB, I_WOUT, I_GFFN, I_WG, I_WU, I_WD, I_GPLE, I_WPG, I_WPP };

__device__ __forceinline__ void p0_tr_item(const float* W, int Nsrc, int K, bf16_t* WT, int dst_row0, int src_col0, int k0, const float* gain, LAS float* scr, int lane) {
    float tv[32];
#pragma unroll
    for (int i = 0; i < 32; ++i) { const int kk = 2 * i + (lane >> 5); tv[i] = __builtin_nontemporal_load(W + (size_t)(k0 + kk) * Nsrc + src_col0 + (lane & 31)); }
    if (gain) {
#pragma unroll
        for (int i = 0; i < 32; ++i) tv[i] *= gain[k0 + 2 * i + (lane >> 5)]; }
#pragma unroll
    for (int i = 0; i < 32; ++i) scr[(2 * i + (lane >> 5)) * 33 + (lane & 31)] = tv[i];
    LDS_WAIT(); asm volatile("" ::: "memory");
    const int c = lane & 7;
#pragma unroll
    for (int j = 0; j < 4; ++j) { const int n = (lane >> 3) + 8 * j; const LAS float* s = scr + (8 * c) * 33 + n;
        u32x4 o; o.x = pk2(s[0 * 33], s[1 * 33]); o.y = pk2(s[2 * 33], s[3 * 33]); o.z = pk2(s[4 * 33], s[5 * 33]); o.w = pk2(s[6 * 33], s[7 * 33]);
        *(u32x4*)(WT + (size_t)(dst_row0 + n) * K + k0 + 8 * c) = o; }
    LDS_WAIT(); asm volatile("" ::: "memory");
}
__device__ __forceinline__ float log_sigmoid(float v) { return v < 0.f ? v - log1pf(expf(v)) : -log1pf(expf(-v)); }

__device__ __forceinline__ void p0_prologue(Frame& F) {
    LAS float* scr = (LAS float*)(F.lds + F.wave * 16384);
    const int gw = blockIdx.x * NWAVES + F.wave, NGW = F.G * NWAVES;
    unsigned char* ws = F.ws;
    constexpr int IT0 = 16 * 176, IT1 = 8 * 32, IT2 = 8 * 32, IT3 = 16 * 32, IT4 = 16 * 176, IT5 = 44 * 32, IT6 = 16 * 32, IT7 = 4 * 32;
    constexpr int NITEMS = IT0 + IT1 + IT2 + IT3 + IT4 + IT5 + IT6 + IT7;
    for (int it = gw; it < NITEMS; it += NGW) {
        int r = it;
        if (r < IT0) { const int kb = r / 176, nb = r % 176, n0 = nb * 32, pn = n0 >> 8, rho = n0 & 255;
            int zc = n0; if (pn >= 8 && pn < 12) { const int bj = rho >> 7, wc = (rho >> 5) & 3; zc = pn * 256 + 64 * wc + 32 * bj; }
            const int src = zc < ZC_GA ? zc : zc + 8;
            p0_tr_item(F.in[I_WIN], INC, 1024, (bf16_t*)(ws + WS_WIN), n0, src, kb * 64, F.in[I_GMIX], scr, F.lane); continue; } r -= IT0;
        if (r < IT1) { p0_tr_item(F.in[I_WA], 1024, 512, (bf16_t*)(ws + WS_WA), (r % 32) * 32, (r % 32) * 32, (r / 32) * 64, nullptr, scr, F.lane); continue; } r -= IT1;
        if (r < IT2) { p0_tr_item(F.in[I_WB], 1024, 512, (bf16_t*)(ws + WS_WB), (r % 32) * 32, (r % 32) * 32, (r / 32) * 64, nullptr, scr, F.lane); continue; } r -= IT2;
        if (r < IT3) { p0_tr_item(F.in[I_WOUT], 1024, 1024, (bf16_t*)(ws + WS_WOUT), (r % 32) * 32, (r % 32) * 32, (r / 32) * 64, nullptr, scr, F.lane); continue; } r -= IT3;
        if (r < IT4) { const int kb = r / 176, nb = r % 176, n0 = nb * 32, pn = n0 >> 8, rho = n0 & 255, bj = rho >> 7, hid = pn * 128 + (rho & 127);
            p0_tr_item(bj ? F.in[I_WU] : F.in[I_WG], DFF, 1024, (bf16_t*)(ws + WS_WGU), n0, hid, kb * 64, F.in[I_GFFN], scr, F.lane); continue; } r -= IT4;
        if (r < IT5) { p0_tr_item(F.in[I_WD], 1024, DFF, (bf16_t*)(ws + WS_WD), (r % 32) * 32, (r % 32) * 32, (r / 32) * 64, nullptr, scr, F.lane); continue; } r -= IT5;
        if (r < IT6) { p0_tr_item(F.in[I_WPG], 1024, 1024, (bf16_t*)(ws + WS_WPG), (r % 32) * 32, (r % 32) * 32, (r / 32) * 64, F.in[I_GPLE], scr, F.lane); continue; } r -= IT6;
        p0_tr_item(F.in[I_WPP], 1024, PLE, (bf16_t*)(ws + WS_WPP), (r % 32) * 32, (r % 32) * 32, (r / 32) * 64, nullptr, scr, F.lane);
    }
    __syncthreads();
    LAS float* wf = (LAS float*)F.lds;
    for (int idx = F.tid; idx < 2048; idx += NTHR) { const int k = idx >> 1, half = idx & 1;
        f32x4 w = *(const f32x4*)(F.in[I_WIN] + (size_t)k * INC + ZC_GA + 4 * half); const float gk = F.in[I_GMIX][k]; w = w * gk;
        const int l = (k & 255) >> 2, e = k & 3, j = k >> 8; *(LAS f32x4*)(wf + (((j * 4 + e) * 64 + l) * 8 + 4 * half)) = w; }
    __syncthreads();
    const float* x = F.in[I_X]; bf16_t* xb = (bf16_t*)(ws + WS_XB); float* rstd = (float*)(ws + WS_RSTD); float* lf = (float*)(ws + WS_LF);
    f32x4 vn[4], vn2[4];
    { const f32x4* xr0 = (const f32x4*)(x + (size_t)(gw < M ? gw : 0) * DMODEL) + F.lane; const f32x4* xr1 = (const f32x4*)(x + (size_t)(gw + NGW < M ? gw + NGW : 0) * DMODEL) + F.lane;
#pragma unroll
      for (int j = 0; j < 4; ++j) vn[j] = __builtin_nontemporal_load(xr0 + 64 * j);
#pragma unroll
      for (int j = 0; j < 4; ++j) vn2[j] = __builtin_nontemporal_load(xr1 + 64 * j); }
    for (int mrow = gw; mrow < M; mrow += NGW) {
        f32x4 v[4]; float ss = 0.f; float a[8];
#pragma unroll
        for (int j = 0; j < 4; ++j) { v[j] = vn[j]; vn[j] = vn2[j]; }
        { const int nrow = mrow + 2 * NGW < M ? mrow + 2 * NGW : mrow; const f32x4* xr2 = (const f32x4*)(x + (size_t)nrow * DMODEL) + F.lane;
#pragma unroll
          for (int j = 0; j < 4; ++j) vn2[j] = __builtin_nontemporal_load(xr2 + 64 * j); }
#pragma unroll
        for (int h = 0; h < 8; ++h) a[h] = 0.f;
#pragma unroll
        for (int j = 0; j < 4; ++j) { ss += (v[j][0] * v[j][0] + v[j][1] * v[j][1]) + (v[j][2] * v[j][2] + v[j][3] * v[j][3]); }
#pragma unroll
        for (int j = 0; j < 4; ++j)
#pragma unroll
            for (int e = 0; e < 4; ++e) { const LAS f32x4* wp = (const LAS f32x4*)(wf + ((j * 4 + e) * 64 + F.lane) * 8); const f32x4 w0 = wp[0], w1 = wp[1]; const float xv = v[j][e];
#pragma unroll
                for (int h = 0; h < 4; ++h) { a[h] += xv * w0[h]; a[4 + h] += xv * w1[h]; } }
        ss = wave_sum(ss);
        const float rs = 1.0f / sqrtf(ss * (1.0f / DMODEL) + EPS);
#pragma unroll
        for (int h = 0; h < 8; ++h) a[h] = wave_sum(a[h]);
        unsigned long long* o8 = (unsigned long long*)(xb + (size_t)mrow * DMODEL) + F.lane;
#pragma unroll
        for (int j = 0; j < 4; ++j) o8[64 * j] = (unsigned long long)pk2(v[j][0] * rs, v[j][1] * rs) | ((unsigned long long)pk2(v[j][2] * rs, v[j][3] * rs) << 32);
        if (F.lane == 0) rstd[mrow] = rs;
        if (F.lane < 8) {
            float av = a[0];
#pragma unroll
            for (int h = 1; h < 8; ++h) av = (F.lane == h) ? a[h] : av;
            const float z = av * rs + F.in[I_FBIAS][F.lane];
            const int b = mrow >> 12, s = mrow & 4095;
            lf[(size_t)(b * 8 + F.lane) * SEQ + s] = log_sigmoid(z);
        }
    }
    { const float* p = F.in[I_P]; bf16_t* pb = (bf16_t*)(ws + WS_PB); const int gt = blockIdx.x * NTHR + F.tid, NT = F.G * NTHR;
#pragma unroll 4
      for (int i = gt; i < M * PLE / 8; i += NT) { const f32x4 a0 = __builtin_nontemporal_load((const f32x4*)(p + (size_t)i * 8)), a1 = __builtin_nontemporal_load((const f32x4*)(p + (size_t)i * 8 + 4));
          u32x4 w; w.x = pk2(a0[0], a0[1]); w.y = pk2(a0[2], a0[3]); w.z = pk2(a1[0], a1[1]); w.w = pk2(a1[2], a1[3]); *(u32x4*)(pb + (size_t)i * 8) = w; } }
}

__device__ __forceinline__ void fox_scan(Frame& F) {
    if (blockIdx.x >= 64) return;
    const int bh = blockIdx.x; const float* lf = (const float*)(F.ws + WS_LF) + (size_t)bh * SEQ; double* cd = (double*)(F.ws + WS_CD) + (size_t)bh * SEQ;
    LAS double* wtot = (LAS double*)F.lds;
    double loc[8]; double run = 0.0;
    { const f32x4 a0 = *(const f32x4*)(lf + F.tid * 8), a1 = *(const f32x4*)(lf + F.tid * 8 + 4);
#pragma unroll
      for (int j = 0; j < 4; ++j) { run += (double)a0[j]; loc[j] = run; }
#pragma unroll
      for (int j = 0; j < 4; ++j) { run += (double)a1[j]; loc[4 + j] = run; } }
    double inc = run;
#pragma unroll
    for (int o = 1; o < 64; o <<= 1) { const double t = __shfl_up(inc, o); if (F.lane >= o) inc += t; }
    if (F.lane == 63) wtot[F.wave] = inc;
    __syncthreads();
    double base = inc - run;
    for (int w = 0; w < F.wave; ++w) base += wtot[w];
#pragma unroll
    for (int j = 0; j < 8; ++j) cd[F.tid * 8 + j] = base + loc[j];
    LAS double* tend = wtot + 8; LAS double* qc = tend + 64;
    if ((F.tid & 7) == 7) tend[F.tid >> 3] = base + loc[7];
    if ((F.tid & 31) == 0) qc[F.tid >> 5] = base + loc[0];
    __syncthreads();
    if (F.tid < 16) { const int qb = F.tid; int cnt = 0; const double c0 = qc[qb];
        for (int t = 0; t < 4 * qb; ++t) { if (tend[t] - c0 >= 66.0 / 1.4426950408889634) cnt = t + 1; else break; }
        ((int*)(F.ws + WS_T0))[bh * 16 + qb] = cnt & ~1; }
    __syncthreads();
}

namespace hg {
constexpr int RAWQ = 0, RAWF = 16384, RAWV = 32768, RAWG = 49152, QT = 65536, KT = QT + 17408, KPT = KT + 17408, AS = KPT + 18432, DL = AS + 9216, TOT = DL + 512, SSQ = TOT + 2048, END = SSQ + 2048;
constexpr int QP = 272, AP = 144;
typedef short v4i16_t __attribute__((ext_vector_type(4)));
#define HBAR() do { asm volatile("s_waitcnt lgkmcnt(0)" ::: "memory"); __builtin_amdgcn_s_barrier(); asm volatile("" ::: "memory"); } while (0)
__device__ __forceinline__ unsigned cvtpk(float lo, float hi) { typedef float f2 __attribute__((ext_vector_type(2))); typedef __bf16 b2 __attribute__((ext_vector_type(2))); f2 v = {lo, hi}; b2 b = __builtin_convertvector(v, b2); return __builtin_bit_cast(unsigned, b); }
__device__ __forceinline__ float ex2(float x) { return __builtin_amdgcn_exp2f(x); }
#define HSB() __builtin_amdgcn_sched_barrier(0)

constexpr int NSEG = 4, CPS = 64 / NSEG;
template <bool FULL> __device__ __forceinline__ void hgrn_unit(int wave_s, bool dostore, int bh, int seg, bf16_t* Z, const float* og, unsigned char* wsb, LAS unsigned char* lds) {
    const int tid = fresh_tid(wave_s);
    const int lane = tid & 63, w = __builtin_amdgcn_readfirstlane(tid >> 6), l15 = lane & 15, g = lane >> 4;
    const int b = bh >> 2, h = bh & 3;
    bf16_t* zb = Z + (size_t)b * SEQ * ZLD + 128 * h;
    if constexpr (FULL) { for (int i = tid; i < 9216 / 4; i += NTHR) ((LAS unsigned*)(lds + AS))[i] = 0u; }
    float* const Ug = (float*)(wsb + WS_HGU); float* const LBg = (float*)(wsb + WS_HGLB); unsigned* const done = (unsigned*)(wsb + WS_CTL) + 256 + 64 * bh;
    const int c0 = seg * CPS, c1 = c0 + CPS;
    f32x4 Sacc[8];
#pragma unroll
    for (int i = 0; i < 8; ++i) Sacc[i] = (f32x4){0.f, 0.f, 0.f, 0.f};
    u32x4 pre[8];
    const int prow = tid >> 4, pch = tid & 15;
#define HG_PREFETCH(c) do { const int cc_ = (c) < c1 ? (c) : c1 - 1; const bf16_t* p_ = zb + (size_t)(cc_ * 64 + prow) * ZLD + pch * 8; \
        _Pragma("unroll") for (int X = 0; X < 4; ++X) if (FULL || X == 1 || X == 2) { pre[2 * X] = *(const u32x4*)(p_ + X * 512); pre[2 * X + 1] = *(const u32x4*)(p_ + (size_t)32 * ZLD + X * 512); } } while (0)
#define HG_STAGE() do { _Pragma("unroll") for (int X = 0; X < 4; ++X) if (FULL || X == 1 || X == 2) { *(LAS u32x4*)(lds + X * 16384 + prow * 256 + pch * 16) = pre[2 * X]; *(LAS u32x4*)(lds + X * 16384 + (prow + 32) * 256 + pch * 16) = pre[2 * X + 1]; } } while (0)
    const int kk = (w & 1) * 64 + lane, tg = w >> 1;
    if (FULL && seg > 0) {
        if (tid == 0) { while (__hip_atomic_load(done, __ATOMIC_RELAXED, __HIP_MEMORY_SCOPE_AGENT) < (unsigned)(NSEG - 1)) __builtin_amdgcn_s_sleep(2);
            __builtin_amdgcn_fence(__ATOMIC_ACQUIRE, "agent"); asm volatile("s_waitcnt vmcnt(0)" ::: "memory"); }
        __syncthreads();
        for (int j = 0; j < seg; ++j) {
            const float* Uj = Ug + ((size_t)((bh * (NSEG - 1) + j) * 8 + w) * 8) * 256; const float* Lj = LBg + (bh * (NSEG - 1) + j) * 128;
#pragma unroll
            for (int kt = 0; kt < 8; ++kt) { const f32x4 u = *(const f32x4*)(Uj + kt * 256 + lane * 4); const f32x4 l4 = *(const f32x4*)(Lj + 16 * kt + 4 * g);
#pragma unroll
                for (int r = 0; r < 4; ++r) Sacc[kt][r] = Sacc[kt][r] * ex2(l4[r] * LOG2E) + u[r]; }
        }
    }
    HG_PREFETCH(c0); HG_STAGE(); HG_PREFETCH(c0 + 1);
    const float gain = og[16 * w + l15];
    float bsum = 0.f;
    for (int c = c0; c < c1; ++c) {
        HBAR();
        float bl[16], qv[16];
        { bf16_t fr_[16], qr_[16];
#pragma unroll
          for (int i = 0; i < 16; ++i) { fr_[i] = *(const LAS bf16_t*)(lds + RAWF + (16 * tg + i) * 256 + kk * 2); qr_[i] = FULL ? *(const LAS bf16_t*)(lds + RAWQ + (16 * tg + i) * 256 + kk * 2) : (bf16_t)0; }
          HSB();
          float run = 0.f;
#pragma unroll
          for (int i = 0; i < 16; ++i) { run += bf1(fr_[i]); bl[i] = run; qv[i] = bf1(qr_[i]); }
          ((LAS float*)(lds + TOT))[tg * 128 + kk] = run; }
        HBAR();
        { const LAS float* tp = (const LAS float*)(lds + TOT) + kk; const float t0 = tp[0], t1 = tp[128], t2 = tp[256], t3 = tp[384];
          HSB();
          const float prefix = (tg > 0 ? t0 : 0.f) + (tg > 1 ? t1 : 0.f) + (tg > 2 ? t2 : 0.f); const float blast = (t0 + t1) + (t2 + t3);
          const float dlv = ex2(blast * LOG2E); bsum += blast;
          unsigned kp[8], wq[16]; float prevb = 0.f, kprev = 0.f;
#pragma unroll
          for (int i = 0; i < 16; ++i) {
              const float lfv = bl[i] - prevb; prevb = bl[i];
              const float bt = prefix + bl[i];
              const float f = ex2(lfv * LOG2E), kf = 1.0f - f;
              const float enb = ex2(-bt * LOG2E);
              if constexpr (FULL) { const float eb = ex2(bt * LOG2E); wq[i] = cvtpk(qv[i] * eb, kf * enb); } else wq[i] = 0u;
              const float kpv = kf * enb * dlv;
              if (i & 1) kp[i >> 1] = cvtpk(kprev, kpv); else kprev = kpv;
          }
          HSB();
          if (tg == 0) ((LAS float*)(lds + DL))[kk] = dlv;
          if constexpr (FULL) {
#pragma unroll
          for (int i = 0; i < 16; ++i) { const int t = 16 * tg + i;
              *(LAS bf16_t*)(lds + QT + t * QP + kk * 2) = (bf16_t)(wq[i] & 0xffffu);
              *(LAS bf16_t*)(lds + KT + t * QP + kk * 2) = (bf16_t)(wq[i] >> 16); } }
          *(LAS u32x4*)(lds + KPT + kk * AP + (16 * tg) * 2) = (u32x4){kp[0], kp[1], kp[2], kp[3]};
          *(LAS u32x4*)(lds + KPT + kk * AP + (16 * tg) * 2 + 16) = (u32x4){kp[4], kp[5], kp[6], kp[7]}; }
        HBAR();
#define HG_ASTILE(ti, tj) do { f32x4 d_ = (f32x4){0.f, 0.f, 0.f, 0.f}; bf16x8 a_[4], b_[4]; \
            _Pragma("unroll") for (int ks = 0; ks < 4; ++ks) { a_[ks] = *(const LAS bf16x8*)(lds + QT + (16 * (ti) + l15) * QP + (32 * ks + 8 * g) * 2); \
                b_[ks] = *(const LAS bf16x8*)(lds + KT + (16 * (tj) + l15) * QP + (32 * ks + 8 * g) * 2); } \
            HSB(); \
            _Pragma("unroll") for (int ks = 0; ks < 4; ++ks) d_ = __builtin_amdgcn_mfma_f32_16x16x32_bf16(a_[ks], b_[ks], d_, 0, 0, 0); \
            _Pragma("unroll") for (int r = 0; r < 4; r += 2) { const int t_ = 16 * (ti) + 4 * g + r, s_ = 16 * (tj) + l15; \
                const unsigned w_ = cvtpk(s_ <= t_ ? d_[r] : 0.f, s_ <= t_ + 1 ? d_[r + 1] : 0.f); \
                *(LAS bf16_t*)(lds + AS + t_ * AP + s_ * 2) = (bf16_t)(w_ & 0xffffu); *(LAS bf16_t*)(lds + AS + (t_ + 1) * AP + s_ * 2) = (bf16_t)(w_ >> 16); } HSB(); } while (0)
        if constexpr (FULL) {
        if (w == 0) { HG_ASTILE(0, 0); HG_ASTILE(3, 0); }
        else if (w == 1) { HG_ASTILE(1, 1); HG_ASTILE(3, 1); }
        else if (w == 2) { HG_ASTILE(2, 2); }
        else if (w == 3) { HG_ASTILE(3, 3); }
        else if (w == 4) { HG_ASTILE(1, 0); }
        else if (w == 5) { HG_ASTILE(2, 0); }
        else if (w == 6) { HG_ASTILE(2, 1); }
        else { HG_ASTILE(3, 2); }
        }
        bf16x8 vf[2]; f32x4 o[4];
        {
            v4i16_t vlo[2], vhi[2];
            const int q_ = l15 >> 2, p_ = lane & 3;
#pragma unroll
            for (int ts = 0; ts < 2; ++ts) {
                vlo[ts] = __builtin_amdgcn_ds_read_tr16_b64_v4i16((LAS v4i16_t*)(lds + RAWV + (32 * ts + 8 * g + q_) * 256 + (16 * w + 4 * p_) * 2));
                vhi[ts] = __builtin_amdgcn_ds_read_tr16_b64_v4i16((LAS v4i16_t*)(lds + RAWV + (32 * ts + 8 * g + 4 + q_) * 256 + (16 * w + 4 * p_) * 2)); }
#pragma unroll
            for (int mt = 0; mt < 4; ++mt) o[mt] = (f32x4){0.f, 0.f, 0.f, 0.f};
            if constexpr (FULL) {
#pragma unroll
            for (int kh = 0; kh < 2; ++kh) {
                u32x2 a0[2][4], a1[2][4];
#pragma unroll
                for (int k2 = 0; k2 < 2; ++k2)
#pragma unroll
                    for (int mt = 0; mt < 4; ++mt) { const int ks = 2 * kh + k2; a0[k2][mt] = *(const LAS u32x2*)(lds + QT + (16 * mt + l15) * QP + (32 * ks + 4 * g) * 2); a1[k2][mt] = *(const LAS u32x2*)(lds + QT + (16 * mt + l15) * QP + (32 * ks + 16 + 4 * g) * 2); }
                HSB();
#pragma unroll
                for (int k2 = 0; k2 < 2; ++k2) { const int ks = 2 * kh + k2;
                    const u32x4 sbw = (u32x4){cvtpk(Sacc[2 * ks][0], Sacc[2 * ks][1]), cvtpk(Sacc[2 * ks][2], Sacc[2 * ks][3]), cvtpk(Sacc[2 * ks + 1][0], Sacc[2 * ks + 1][1]), cvtpk(Sacc[2 * ks + 1][2], Sacc[2 * ks + 1][3])};
                    const bf16x8 sb = __builtin_bit_cast(bf16x8, sbw);
#pragma unroll
                    for (int mt = 0; mt < 4; ++mt) { const bf16x8 aq = __builtin_bit_cast(bf16x8, (u32x4){a0[k2][mt].x, a0[k2][mt].y, a1[k2][mt].x, a1[k2][mt].y});
                        o[mt] = __builtin_amdgcn_mfma_f32_16x16x32_bf16(aq, sb, o[mt], 0, 0, 0); } }
                HSB();
            }
            } else { HSB(); }
#pragma unroll
            for (int ts = 0; ts < 2; ++ts) vf[ts] = (bf16x8){vlo[ts][0], vlo[ts][1], vlo[ts][2], vlo[ts][3], vhi[ts][0], vhi[ts][1], vhi[ts][2], vhi[ts][3]};
        }
#pragma unroll
        for (int hb = 0; hb < 2; ++hb) {
            bf16x8 akp[4][2]; f32x4 dl4[4];
#pragma unroll
            for (int k4 = 0; k4 < 4; ++k4) { const int kt = 4 * hb + k4; dl4[k4] = *(const LAS f32x4*)(lds + DL + (16 * kt + 4 * g) * 4);
#pragma unroll
                for (int ts = 0; ts < 2; ++ts) akp[k4][ts] = *(const LAS bf16x8*)(lds + KPT + (16 * kt + l15) * AP + (32 * ts + 8 * g) * 2); }
            HSB();
#pragma unroll
            for (int ts = 0; ts < 2; ++ts)
#pragma unroll
                for (int k4 = 0; k4 < 4; ++k4) { const int kt = 4 * hb + k4; const f32x4 cin = ts == 0 ? Sacc[kt] * dl4[k4] : Sacc[kt];
                    Sacc[kt] = __builtin_amdgcn_mfma_f32_16x16x32_bf16(akp[k4][ts], vf[ts], cin, 0, 0, 0); }
            HSB();
        }
        float gv[4][4];
        if constexpr (FULL) {
        { bf16_t gr_[4][4];
#pragma unroll
          for (int mt = 0; mt < 4; ++mt)
#pragma unroll
              for (int r = 0; r < 4; ++r) gr_[mt][r] = *(const LAS bf16_t*)(lds + RAWG + (16 * mt + 4 * g + r) * 256 + (16 * w + l15) * 2);
          HSB();
#pragma unroll
          for (int mt = 0; mt < 4; ++mt)
#pragma unroll
              for (int r = 0; r < 4; ++r) gv[mt][r] = bf1(gr_[mt][r]); }
        HBAR();
        { bf16x8 aa[4][2];
#pragma unroll
          for (int mt = 0; mt < 4; ++mt)
#pragma unroll
              for (int ks = 0; ks < 2; ++ks) { if (ks == 1 && mt < 2) continue; aa[mt][ks] = *(const LAS bf16x8*)(lds + AS + (16 * mt + l15) * AP + (32 * ks + 8 * g) * 2); }
          HSB();
#pragma unroll
          for (int ks = 0; ks < 2; ++ks)
#pragma unroll
              for (int mt = 0; mt < 4; ++mt) { if (ks == 1 && mt < 2) continue; o[mt] = __builtin_amdgcn_mfma_f32_16x16x32_bf16(aa[mt][ks], vf[ks], o[mt], 0, 0, 0); }
          HSB(); }
#pragma unroll
        for (int mt = 0; mt < 4; ++mt)
#pragma unroll
            for (int r = 0; r < 4; ++r) { const float ss = row16_sum(o[mt][r] * o[mt][r]);
                if (l15 == 0) ((LAS float*)(lds + SSQ))[(16 * mt + 4 * g + r) * 8 + w] = ss; }
        }
        HBAR();
        HG_STAGE(); HG_PREFETCH(c + 2);
        if constexpr (FULL) {
        bf16_t* yb = zb + (size_t)(c * 64) * ZLD + ZC_I + 16 * w + l15;
#pragma unroll
        for (int mt = 0; mt < 4; ++mt) { f32x4 s0[4], s1[4];
#pragma unroll
            for (int r = 0; r < 4; ++r) { const LAS f32x4* sp = (const LAS f32x4*)(lds + SSQ + (16 * mt + 4 * g + r) * 32); s0[r] = sp[0]; s1[r] = sp[1]; }
            HSB();
#pragma unroll
            for (int r = 0; r < 4; ++r) { const int t = 16 * mt + 4 * g + r; const f32x4 u0 = s0[r], u1 = s1[r];
                const float tot = ((u0[0] + u0[1]) + (u0[2] + u0[3])) + ((u1[0] + u1[1]) + (u1[2] + u1[3]));
                const float rs = __builtin_amdgcn_rsqf(tot * (1.0f / 128.0f) + EPS);
                if (dostore) yb[(size_t)t * ZLD] = (bf16_t)f2bf(o[mt][r] * rs * gain * gv[mt][r]); }
            HSB(); }
            }
}
    if constexpr (!FULL) {
        float* Uo = Ug + ((size_t)((bh * (NSEG - 1) + seg) * 8 + w) * 8) * 256;
#pragma unroll
        for (int kt = 0; kt < 8; ++kt) *(f32x4*)(Uo + kt * 256 + lane * 4) = Sacc[kt];
        if (tg == 0) LBg[(bh * (NSEG - 1) + seg) * 128 + kk] = bsum;
        asm volatile("s_waitcnt vmcnt(0)" ::: "memory");
        __syncthreads();
        if (tid == 0) { __builtin_amdgcn_fence(__ATOMIC_RELEASE, "agent"); asm volatile("s_waitcnt vmcnt(0)" ::: "memory"); __hip_atomic_fetch_add(done, 1u, __ATOMIC_RELAXED, __HIP_MEMORY_SCOPE_AGENT); }
    }
#undef HG_PREFETCH
#undef HG_STAGE
#undef HG_ASTILE
}
}

constexpr int QSLOT_OFF = LDS_BYTES - 64;
constexpr int N_P1 = 32 * (hg::NSEG - 1), N_S0 = 32, N_FOXA = 128, N_P2 = 32 * (hg::NSEG - 1), N_FOX = 64 * 16;
constexpr int N_ITEMS = N_P1 + N_S0 + N_P2 + N_FOX;
static_assert(hg::END <= QSLOT_OFF && attn_body::ATTN_LDS_BYTES <= QSLOT_OFF, "LDS map");
__device__ __forceinline__ void mix_phase(Frame& F, unsigned char* ldsg) {
    unsigned* ctr = (unsigned*)(F.ws + WS_CTL);
    LAS int* slot = (LAS int*)(F.lds + QSLOT_OFF);
    const attn_body::bf16* Zb = (const attn_body::bf16*)(F.ws + WS_Z);
    for (;;) {
        if (F.tid == 0) *slot = (int)atomicAdd(ctr, 1u);
        __syncthreads();
        const int item = __builtin_amdgcn_readfirstlane(*slot);
        __syncthreads();
        if (item >= N_ITEMS) break;
        int fox = -1;
        if (item < N_P1) hg::hgrn_unit<false>(F.wave0, true, item / (hg::NSEG - 1), item % (hg::NSEG - 1), (bf16_t*)(F.ws + WS_Z), F.in[I_ONG], F.ws, F.lds);
        else if (item < N_P1 + N_S0) hg::hgrn_unit<true>(F.wave0, true, item - N_P1, 0, (bf16_t*)(F.ws + WS_Z), F.in[I_ONG], F.ws, F.lds);
        else if (item < N_P1 + N_S0 + N_FOXA) fox = item - (N_P1 + N_S0);
        else if (item < N_P1 + N_S0 + N_FOXA + N_P2) { const int j = item - (N_P1 + N_S0 + N_FOXA); hg::hgrn_unit<true>(F.wave0, true, j / (hg::NSEG - 1), 1 + j % (hg::NSEG - 1), (bf16_t*)(F.ws + WS_Z), F.in[I_ONG], F.ws, F.lds); }
        else fox = item - (N_P1 + N_S0 + N_P2);
        if (fox >= 0) { const int qb = 15 - (fox >> 6), bh = fox & 63;
          attn_body::attn_unit<8>(F.wave0, true, bh >> 3, bh & 7, qb, __builtin_amdgcn_readfirstlane(((const int*)(F.ws + WS_T0))[bh * 16 + qb]), (const double*)(F.ws + WS_CD) + (size_t)bh * SEQ, Zb + ZC_FQ, Zb + ZC_FK, Zb + ZC_FV, (attn_body::bf16*)(Zb + ZC_FQ), (char*)ldsg); }
    }
}

#define XB_TMO      128
#define XB_XCNT(j)  (256  + 64 * (j))
#define XB_XSUB(j)  (1280 + 64 * (j))
#define XB_XGEN(j)  (2304 + 64 * (j))
#define XB_TOP      3328
#define XB_TOPGEN   3392
#define XB_SPIN_CAP (1u << 22)
__device__ __forceinline__ unsigned xb_ld(unsigned* p)              { return __hip_atomic_load(p, __ATOMIC_RELAXED, __HIP_MEMORY_SCOPE_AGENT); }
__device__ __forceinline__ unsigned xb_add(unsigned* p, unsigned v) { return __hip_atomic_fetch_add(p, v, __ATOMIC_RELAXED, __HIP_MEMORY_SCOPE_AGENT); }
__device__ __forceinline__ unsigned xb_xcc_id() { return (unsigned)__builtin_amdgcn_s_getreg((3 << 11) | 20) & 0xFu; }
#define XB_SPIN(cond, bar) do { unsigned _sp = 0; while (cond) { __builtin_amdgcn_s_sleep(1); \
    if ((++_sp & 255u) == 0u) { if (xb_ld(&(bar)[XB_TMO])) break; if (_sp > XB_SPIN_CAP) { atomicAdd(&(bar)[XB_TMO], 1u); break; } } } } while (0)
__device__ __forceinline__ void xcd_barrier_complete(unsigned* bar, unsigned x, unsigned G, unsigned& nloc, unsigned& nx) {
    unsigned sum, cnt, mine, sp = 0u;
    for (;;) {
        sum = 0u; cnt = 0u; mine = 0u;
#pragma unroll
        for (unsigned j = 0; j < 16; ++j) { const unsigned c = xb_ld(&bar[XB_XCNT(j)]); sum += c; cnt += (c > 0u) ? 1u : 0u; mine = (j == x) ? c : mine; }
        if (sum == G) break;
        __builtin_amdgcn_s_sleep(1);
        if ((++sp & 255u) == 0u) { if (xb_ld(&bar[XB_TMO])) break; if (sp > XB_SPIN_CAP) { atomicAdd(&bar[XB_TMO], 1u); break; } }
    }
    nloc = mine > 0u ? mine : 1u; nx = cnt > 0u ? cnt : 1u;
}
__device__ __forceinline__ void grid_barrier(Frame& F, unsigned* bar, int) {
    const int t = fresh_tid(F.wave0);
    volatile LAS unsigned* st = (volatile LAS unsigned*)(F.lds + QSLOT_OFF + 16);
    asm volatile("s_waitcnt vmcnt(0)" ::: "memory");
    __syncthreads();
    if (t == 0) {
        const unsigned x = xb_xcc_id();
        __builtin_amdgcn_s_waitcnt(0);
        unsigned nloc = st[0], nx = st[1];
        if (nloc == 0u) { xcd_barrier_complete(bar, x, (unsigned)F.G, nloc, nx); st[0] = nloc; st[1] = nx; }
        const unsigned old = xb_add(&bar[XB_XSUB(x)], 1u);
        const unsigned gen = old / nloc;
        if (old + 1u == (gen + 1u) * nloc) {
            __builtin_amdgcn_fence(__ATOMIC_RELEASE, "agent");
            asm volatile("s_waitcnt vmcnt(0)" ::: "memory");
            const unsigned og = xb_add(&bar[XB_TOP], 1u);
            const unsigned tg = og / nx;
            if (og + 1u == (tg + 1u) * nx) xb_add(&bar[XB_TOPGEN], 1u);
            else XB_SPIN(xb_ld(&bar[XB_TOPGEN]) == tg, bar);
            __builtin_amdgcn_fence(__ATOMIC_ACQUIRE, "agent");
            xb_add(&bar[XB_XGEN(x)], 1u);
            asm volatile("s_waitcnt vmcnt(0)" ::: "memory");
        } else {
            XB_SPIN(xb_ld(&bar[XB_XGEN(x)]) == gen, bar);
            __builtin_amdgcn_fence(__ATOMIC_ACQUIRE, "agent");
            asm volatile("s_waitcnt vmcnt(0)" ::: "memory");
        }
    }
    __syncthreads();
}
template <class Epi> __device__ __forceinline__ void run_gemm(Frame& F, const pg8::Gemm& g, const Epi& E) {
    pg8::StaticOrder S; S.init(g.M, g.N, F.G, (int)blockIdx.x);
    pg8::gemm_phase<Epi, true, true>(F.wave0, F.lds, g, S, E);
}

__global__ void __launch_bounds__(NTHR, 2) skel_fwd(Args args) {
    extern __shared__ __attribute__((aligned(16))) unsigned char lds[];
    Frame F;
    F.lds = (LAS unsigned char*)lds; F.tid = 0; F.lane = 0; F.wave = 0; F.G = gridDim.x; F.wave0 = __builtin_amdgcn_readfirstlane((int)threadIdx.x >> 6);
#pragma unroll
    for (int i = 0; i < 19; ++i) F.in[i] = args.in[i];
    F.out = args.out; F.ws = args.ws;
    unsigned char* ws = args.ws;
    bf16_t* Z = (bf16_t*)(ws + WS_Z); bf16_t* XB = (bf16_t*)(ws + WS_XB);
    const int ph = args.ph;
    int seam_no = 0; (void)seam_no;
#if ONE_LAUNCH
    { const int t0_ = fresh_tid(F.wave0); if (t0_ == 0) { volatile LAS unsigned* st = (volatile LAS unsigned*)(F.lds + QSLOT_OFF + 16); st[0] = 0u; st[1] = 0u; (void)xb_add((unsigned*)(ws + WS_CTL) + 8192 + XB_XCNT(xb_xcc_id()), 1u); } __syncthreads(); }
#endif
    if (ph == 0x7ffffff0) cg::this_grid().sync();
#define FRESH() do { const int t_ = fresh_tid(F.wave0); F.tid = t_; F.lane = t_ & 63; F.wave = __builtin_amdgcn_readfirstlane(t_ >> 6); } while (0)
#define IN(k) (ph < 0 || ph == (k))
#if ONE_LAUNCH
#define SEAM() grid_barrier(F, (unsigned*)(ws + WS_CTL) + 8192, seam_no++)
#else
#define SEAM() do {} while (0)
#endif
    if (IN(0)) { FRESH(); p0_prologue(F); SEAM(); }
    if (IN(1)) {
        FRESH(); fox_scan(F);
        pg8::Gemm g{XB, (const bf16_t*)(ws + WS_WIN), M, ZLD, 1024, 1024};
        pg8::EpiIn E{Z, (const float*)(ws + WS_RSTD), F.in[I_LBL], F.in[I_QG], F.in[I_KG]};
        run_gemm(F, g, E);
        SEAM();
    }
    if (IN(2)) {
        FRESH(); mix_phase(F, lds);
        SEAM();
    }
    if (IN(3)) {
        { pg8::Gemm g{Z + ZC_FQ, (const bf16_t*)(ws + WS_WB), M, 1024, 1024, ZLD, 512, Z + ZC_I, (const bf16_t*)(ws + WS_WA), 8};
          pg8::EpiGate E{XB, 1024, Z + ZC_GA, Z + ZC_GB, ZLD}; run_gemm(F, g, E); }
        SEAM();
    }
    if (IN(4)) {
        pg8::Gemm g{XB, (const bf16_t*)(ws + WS_WOUT), M, 1024, 1024, 1024};
        pg8::EpiResid<false> E{F.in[I_X], nullptr, (bf16_t*)(ws + WS_X1B), (float*)(ws + WS_SSQ1)};
        run_gemm(F, g, E); SEAM();
    }
    if (IN(5)) {
        pg8::Gemm g{(const bf16_t*)(ws + WS_X1B), (const bf16_t*)(ws + WS_WGU), M, 2 * DFF, 1024, 1024};
        pg8::EpiSwiglu E{(bf16_t*)(ws + WS_H), (const float*)(ws + WS_SSQ1)};
        run_gemm(F, g, E);
        SEAM();
    }
    if (IN(6)) {
        pg8::Gemm g{(const bf16_t*)(ws + WS_H), (const bf16_t*)(ws + WS_WD), M, 1024, DFF, DFF};
        pg8::EpiResid<true> E{nullptr, (const bf16_t*)(ws + WS_X1B), XB, (float*)(ws + WS_SSQ2)};
        run_gemm(F, g, E); SEAM();
    }
    if (IN(7)) {
        { pg8::Gemm g{(const bf16_t*)(ws + WS_PB), (const bf16_t*)(ws + WS_WPP), M, 1024, PLE, PLE}; pg8::EpiPlain E{(bf16_t*)(ws + WS_PP), 1024}; run_gemm(F, g, E); }
        { pg8::Gemm g{XB, (const bf16_t*)(ws + WS_WPG), M, 1024, 1024, 1024}; pg8::EpiPle E{F.out, XB, (const bf16_t*)(ws + WS_PP), (const float*)(ws + WS_SSQ2)}; run_gemm(F, g, E); }
    }
#undef IN
#undef SEAM
}

extern "C" void kernel_launch(void* const* d_in, const int* in_sizes, int n_in, void* d_out, int out_size, void* d_ws, size_t ws_size, hipStream_t stream) {
    static int grid = 0;
    if (grid == 0) {
        if (n_in != 19 || out_size != M * DMODEL || ws_size < WS_END) { fprintf(stderr, "kernel_launch: unexpected shapes (n_in %d out %d ws %zu)\n", n_in, out_size, ws_size); grid = -1; return; }
        int dev = 0, cus = 0, per_cu = 0;
        hipGetDevice(&dev); hipDeviceGetAttribute(&cus, hipDeviceAttributeMultiprocessorCount, dev);
        hipFuncSetAttribute((const void*)skel_fwd, hipFuncAttributeMaxDynamicSharedMemorySize, LDS_BYTES);
        hipOccupancyMaxActiveBlocksPerMultiprocessor(&per_cu, (const void*)skel_fwd, NTHR, LDS_BYTES);
        if (per_cu < 1) per_cu = 1;
        (void)hipGetLastError();
        grid = cus * per_cu;
    }
    if (grid < 0) return;
    hipMemsetAsync((char*)d_ws + WS_CTL, 0, CTL_ZERO_BYTES, stream);
    Args a{};
    for (int i = 0; i < 19; ++i) a.in[i] = (const float*)d_in[i];
    a.out = (float*)d_out; a.ws = (unsigned char*)d_ws;
#if ONE_LAUNCH
    a.ph = -1;
    void* kargs[] = {&a};
    hipError_t e = hipLaunchCooperativeKernel((const void*)skel_fwd, dim3(grid), dim3(NTHR), kargs, LDS_BYTES, stream);
    if (e != hipSuccess) fprintf(stderr, "cooperative launch failed: %s (grid %d)\n", hipGetErrorString(e), grid);
#else
    const int phases[] = {0, 1, 2, 3, 4, 5, 6, 7};
    for (int ph : phases) { a.ph = ph; hipLaunchKernelGGL(skel_fwd, dim3(grid), dim3(NTHR), LDS_BYTES, stream, a); }
#endif
}
```
